# Optimizing an MI355X kernel written in HIP

```python
import math
import jax, jax.numpy as jnp
from jax import lax
import numpy as np

D_MODEL = 2048
BATCH = 4
SEQ = 2048
DEPTH = 1
DEC_BATCH = 128
DEC_SEQ = 8
PAST_LEN = 16384
PAGE_SIZE = 128

D_SSM = D_MODEL // 2
SSM_GROUP_CH = 16
SSM_GROUPS = D_SSM // SSM_GROUP_CH
SSM_STATE = 64
DT_MIN = 1e-3
DT_MAX = 1e-1
D_CONV = D_MODEL // 2
CONV_WIDTH = 3
N_IN = 2 * D_SSM + 4 * D_CONV + 2 * D_MODEL
SPLIT_POINTS = (D_SSM, 2 * D_SSM, 2 * D_SSM + D_CONV, 2 * D_SSM + 2 * D_CONV,
                2 * D_SSM + 3 * D_CONV, 2 * D_SSM + 4 * D_CONV,
                2 * D_SSM + 4 * D_CONV + D_MODEL)
DN_ALPHA = (2 * DEPTH) ** 0.25
DN_BETA = (8 * DEPTH) ** -0.25
LN_EPS = 1e-5

kernel_name = 's5_shortconv_gated_hybrid_step'


def _complex_scan_combine(left, right):
    a1r, a1i, b1r, b1i = left
    a2r, a2i, b2r, b2i = right
    ar = a2r * a1r - a2i * a1i
    ai = a2r * a1i + a2i * a1r
    br = a2r * b1r - a2i * b1i + b2r
    bi = a2r * b1i + a2i * b1r + b2i
    return ar, ai, br, bi


def ssm_branch(u, h0_re, h0_im, a_re, a_im, log_dt, b_re, b_im, c_re, c_im, d, w_glu):
    f32 = jnp.float32
    bt, L, _ = u.shape
    a_re = a_re.astype(f32)
    a_im = a_im.astype(f32)
    dt = jnp.exp(log_dt.astype(f32))[:, None]
    mag = jnp.exp(a_re * dt)
    ang = a_im * dt
    lam_re = mag * jnp.cos(ang)
    lam_im = mag * jnp.sin(ang)
    den = a_re * a_re + a_im * a_im
    q_re = ((lam_re - 1.0) * a_re + lam_im * a_im) / den
    q_im = (lam_im * a_re - (lam_re - 1.0) * a_im) / den
    b_re = b_re.astype(f32)
    b_im = b_im.astype(f32)
    bb_re = q_re[..., None] * b_re - q_im[..., None] * b_im
    bb_im = q_re[..., None] * b_im + q_im[..., None] * b_re
    uf = u.astype(f32)
    ug = uf.reshape(bt, L, SSM_GROUPS, SSM_GROUP_CH)
    bu_re = jnp.einsum('blgc,gpc->blgp', ug, bb_re)
    bu_im = jnp.einsum('blgc,gpc->blgp', ug, bb_im)
    lam_re_t = jnp.broadcast_to(lam_re, (1, L, SSM_GROUPS, SSM_STATE))
    lam_im_t = jnp.broadcast_to(lam_im, (1, L, SSM_GROUPS, SSM_STATE))
    pw_re, pw_im, h_re, h_im = lax.associative_scan(
        _complex_scan_combine, (lam_re_t, lam_im_t, bu_re, bu_im), axis=1)
    if h0_re is not None:
        h0r = h0_re.astype(f32)[:, None]
        h0i = h0_im.astype(f32)[:, None]
        h_re = h_re + pw_re * h0r - pw_im * h0i
        h_im = h_im + pw_re * h0i + pw_im * h0r
    y = (jnp.einsum('blgp,gcp->blgc', h_re, c_re.astype(f32))
         - jnp.einsum('blgp,gcp->blgc', h_im, c_im.astype(f32)))
    y = y.reshape(bt, L, D_SSM) + d.astype(f32) * uf
    y = jax.nn.gelu(y)
    y = y * jax.nn.sigmoid(y @ w_glu.astype(f32))
    return y.astype(u.dtype), h_re[:, -1], h_im[:, -1]


def conv_branch(b_c, c_c, h_c, buf, conv_w):
    q = c_c * h_c
    bt, L, _ = q.shape
    if buf is None:
        buf = jnp.zeros((bt, CONV_WIDTH - 1, D_CONV), q.dtype)
    padded = jnp.concatenate([buf.astype(q.dtype), q], axis=1)
    conv = padded[:, 0:L] * conv_w[0]
    for k in range(1, CONV_WIDTH):
        conv = conv + padded[:, k:k + L] * conv_w[k]
    return b_c * conv, padded[:, -(CONV_WIDTH - 1):]


def hybrid_layer(x, h0_re, h0_im, conv_buf, w_in, a_re, a_im, log_dt, b_re, b_im,
                 c_re, c_im, d, w_glu, w_out_a, conv_w, w_out_c, w_o, ln_g, ln_b):
    proj = jnp.einsum('bld,dn->bln', x, w_in)
    u_a, z_a, b_c, c_c, h_c, z_c, g_a, g_c = jnp.split(proj, SPLIT_POINTS, axis=-1)
    y_a, hr, hi = ssm_branch(u_a, h0_re, h0_im, a_re, a_im, log_dt, b_re, b_im,
                             c_re, c_im, d, w_glu)
    y_a = (y_a * jax.nn.silu(z_a)) @ w_out_a
    y_c, new_buf = conv_branch(b_c, c_c, h_c, conv_buf, conv_w)
    y_c = (y_c * jax.nn.silu(z_c)) @ w_out_c
    merged = jax.nn.sigmoid(g_a) * y_a + jax.nn.sigmoid(g_c) * y_c
    out = merged @ w_o
    r = (DN_ALPHA * x + out).astype(jnp.float32)
    mu = jnp.mean(r, axis=-1, keepdims=True)
    rc = r - mu
    var = jnp.mean(rc * rc, axis=-1, keepdims=True)
    y = rc * lax.rsqrt(var + LN_EPS) * ln_g.astype(jnp.float32) + ln_b.astype(jnp.float32)
    return y.astype(x.dtype), hr, hi, new_buf


def setup_inputs(seed: int = 0) -> dict:
    key = jax.random.key(seed)
    ks = jax.random.split(key, 24)
    f32 = jnp.float32
    nrm = lambda k, shape, s: jax.random.normal(k, shape, f32) * s
    G, P, GC = SSM_GROUPS, SSM_STATE, SSM_GROUP_CH
    x_prompt = nrm(ks[0], (BATCH, SEQ, D_MODEL), 1.0)
    x_sample = nrm(ks[1], (DEC_BATCH, DEC_SEQ, D_MODEL), 1.0)
    state_ssm_re = nrm(ks[2], (DEPTH, DEC_BATCH, G, P), 0.3)
    state_ssm_im = nrm(ks[3], (DEPTH, DEC_BATCH, G, P), 0.3)
    state_conv = nrm(ks[4], (DEPTH, DEC_BATCH, CONV_WIDTH - 1, D_CONV), 1.0)
    w_in = nrm(ks[5], (DEPTH, D_MODEL, N_IN), D_MODEL ** -0.5)
    ssm_a_re = -0.5 + nrm(ks[6], (DEPTH, G, P), 0.01)
    n_idx = jnp.arange(P, dtype=f32) * math.pi
    ssm_a_im = n_idx + nrm(ks[7], (DEPTH, G, P), 0.01)
    ssm_log_dt = jax.random.uniform(ks[8], (DEPTH, G), f32,
                                    math.log(DT_MIN), math.log(DT_MAX))
    ssm_b_re = nrm(ks[9], (DEPTH, G, P, GC), (2 * GC) ** -0.5)
    ssm_b_im = nrm(ks[10], (DEPTH, G, P, GC), (2 * GC) ** -0.5)
    ssm_c_re = nrm(ks[11], (DEPTH, G, GC, P), P ** -0.5)
    ssm_c_im = nrm(ks[12], (DEPTH, G, GC, P), P ** -0.5)
    ssm_d = nrm(ks[13], (DEPTH, D_SSM), 1.0)
    w_glu = nrm(ks[14], (DEPTH, D_SSM, D_SSM), D_SSM ** -0.5)
    w_out_a = nrm(ks[15], (DEPTH, D_SSM, D_MODEL), DN_BETA * D_SSM ** -0.5)
    conv_w = nrm(ks[16], (DEPTH, CONV_WIDTH, D_CONV), CONV_WIDTH ** -0.5)
    w_out_c = nrm(ks[17], (DEPTH, D_CONV, D_MODEL), DN_BETA * D_CONV ** -0.5)
    w_o = nrm(ks[18], (DEPTH, D_MODEL, D_MODEL), DN_BETA * D_MODEL ** -0.5)
    ln_g = 1.0 + nrm(ks[19], (DEPTH, D_MODEL), 0.01)
    ln_b = nrm(ks[20], (DEPTH, D_MODEL), 0.01)
    return {'x_prompt': x_prompt, 'x_sample': x_sample,
            'state_ssm_re': state_ssm_re, 'state_ssm_im': state_ssm_im,
            'state_conv': state_conv, 'w_in': w_in,
            'ssm_a_re': ssm_a_re, 'ssm_a_im': ssm_a_im, 'ssm_log_dt': ssm_log_dt,
            'ssm_b_re': ssm_b_re, 'ssm_b_im': ssm_b_im,
            'ssm_c_re': ssm_c_re, 'ssm_c_im': ssm_c_im, 'ssm_d': ssm_d,
            'w_glu': w_glu, 'w_out_a': w_out_a, 'conv_w': conv_w,
            'w_out_c': w_out_c, 'w_o': w_o, 'ln_g': ln_g, 'ln_b': ln_b}


def reference(x_prompt, x_sample, state_ssm_re, state_ssm_im, state_conv, w_in,
              ssm_a_re, ssm_a_im, ssm_log_dt, ssm_b_re, ssm_b_im, ssm_c_re, ssm_c_im,
              ssm_d, w_glu, w_out_a, conv_w, w_out_c, w_o, ln_g, ln_b):
    xp = x_prompt
    xs = x_sample
    sre_p, sim_p, cnv_p = [], [], []
    sre_s, sim_s, cnv_s = [], [], []
    for l in range(DEPTH):
        params = (w_in[l], ssm_a_re[l], ssm_a_im[l], ssm_log_dt[l], ssm_b_re[l],
                  ssm_b_im[l], ssm_c_re[l], ssm_c_im[l], ssm_d[l], w_glu[l],
                  w_out_a[l], conv_w[l], w_out_c[l], w_o[l], ln_g[l], ln_b[l])
        xp, hr, hi, cb = hybrid_layer(xp, None, None, None, *params)
        sre_p.append(hr)
        sim_p.append(hi)
        cnv_p.append(cb)
        xs, hr, hi, cb = hybrid_layer(xs, state_ssm_re[l], state_ssm_im[l],
                                      state_conv[l], *params)
        sre_s.append(hr)
        sim_s.append(hi)
        cnv_s.append(cb)
    new_ssm_re_prompt = jnp.stack(sre_p, axis=0)
    new_ssm_im_prompt = jnp.stack(sim_p, axis=0)
    new_conv_prompt = jnp.stack(cnv_p, axis=0)
    new_ssm_re_sample = jnp.stack(sre_s, axis=0)
    new_ssm_im_sample = jnp.stack(sim_s, axis=0)
    new_conv_sample = jnp.stack(cnv_s, axis=0)
    return (xp, xs, new_ssm_re_prompt, new_ssm_im_prompt, new_conv_prompt,
            new_ssm_re_sample, new_ssm_im_sample, new_conv_sample)
```

```cpp
#include <hip/hip_runtime.h>
#include <hip/hip_cooperative_groups.h>
#include <cstdio>
namespace cg = cooperative_groups;

#ifndef MK_SINGLE
#define MK_SINGLE 1
#endif

#define LAS __attribute__((address_space(3)))
typedef unsigned short bf16_t;
typedef short bf16x8 __attribute__((ext_vector_type(8)));
typedef float f32x4 __attribute__((ext_vector_type(4)));
typedef unsigned u32x4 __attribute__((ext_vector_type(4)));
typedef unsigned u32x2 __attribute__((ext_vector_type(2)));

constexpr int D_MODEL = 2048, MP = 8192, MS = 1024, MT = MP + MS, SEQ = 2048, NIN = 10240;
constexpr int DS = 1024, NG = 64;
constexpr float DN_ALPHA = 1.189207115002721f;
constexpr float LN_EPS = 1e-5f;
constexpr size_t O_Y = 0, O_SRP = (size_t)MT * D_MODEL, O_SIP = O_SRP + 16384, O_CVP = O_SIP + 16384, O_SRS = O_CVP + 8192, O_SIS = O_SRS + 524288, O_CVS = O_SIS + 524288;
constexpr size_t SZ_X = (size_t)MT * D_MODEL * 2;
constexpr size_t SZ_H = (size_t)MT * DS * 2;
constexpr size_t W_XB = 0;
constexpr size_t W_WINT = W_XB + SZ_X;
constexpr size_t W_WGLUT = W_WINT + (size_t)NIN * D_MODEL * 2;
constexpr size_t W_WOACT = W_WGLUT + (size_t)DS * DS * 2;
constexpr size_t W_WOT = W_WOACT + (size_t)2 * D_MODEL * DS * 2;
constexpr size_t W_PU = W_WOT + (size_t)D_MODEL * D_MODEL * 2;
constexpr size_t W_PZA = W_PU + SZ_H;
constexpr size_t W_PB = W_PZA + SZ_H;
constexpr size_t W_PC = W_PB + SZ_H;
constexpr size_t W_PH = W_PC + SZ_H;
constexpr size_t W_PZC = W_PH + SZ_H;
constexpr size_t W_PGA = W_PZC + SZ_H;
constexpr size_t W_PGC = W_PGA + SZ_X;
constexpr size_t W_BAR = W_PGC + SZ_X;
constexpr size_t W_CTL = W_BAR + 16384;
constexpr size_t W_G1 = W_CTL + 32768;
constexpr size_t W_END = W_G1 + SZ_H;
constexpr size_t W_YAC = W_WINT;
constexpr size_t W_MG = W_PB;

struct Params {
    const float *x_prompt, *x_sample, *st_re, *st_im, *st_conv, *w_in, *a_re, *a_im, *log_dt, *b_re, *b_im, *c_re, *c_im, *ssm_d, *w_glu, *w_out_a, *conv_w, *w_out_c, *w_o, *ln_g, *ln_b;
    float* out;
    unsigned char* ws;
};

typedef __bf16 bf16v2 __attribute__((ext_vector_type(2)));
typedef float f32v2 __attribute__((ext_vector_type(2)));
__device__ __forceinline__ unsigned cvt_pk_bf16(float lo, float hi) { const f32v2 v = {lo, hi}; const bf16v2 b = __builtin_convertvector(v, bf16v2); return __builtin_bit_cast(unsigned, b); }
__device__ __forceinline__ int tid_opaque() { int t = threadIdx.x; asm volatile("" : "+v"(t)); return t; }
__device__ __forceinline__ float bf_lo(unsigned w) { return __uint_as_float(w << 16); }
__device__ __forceinline__ float bf_hi(unsigned w) { return __uint_as_float(w & 0xffff0000u); }
__device__ __forceinline__ bf16_t f2bf(float f) { return (bf16_t)(cvt_pk_bf16(f, 0.f) & 0xffffu); }
__device__ __forceinline__ float sigmoidf_(float x) { return __builtin_amdgcn_rcpf(1.0f + __expf(-x)); }
__device__ __forceinline__ float siluf_(float x) { return x * sigmoidf_(x); }
__device__ __forceinline__ float gelu_tanh(float y) { const float z = 0.7978845608028654f * (y + 0.044715f * y * y * y); return y * sigmoidf_(2.0f * z); }

#define XB_TMO      128
#define XB_XCNT(j)  (256  + 64 * (j))
#define XB_XSUB(j)  (1280 + 64 * (j))
#define XB_XGEN(j)  (2304 + 64 * (j))
#define XB_TOP      3328
#define XB_TOPGEN   3392
#define XCD_BAR_WORDS 3456
#define XB_SPIN_CAP (1u << 18)
__device__ __forceinline__ unsigned xb_ld(unsigned* p)              { return __hip_atomic_load(p, __ATOMIC_RELAXED, __HIP_MEMORY_SCOPE_AGENT); }
__device__ __forceinline__ unsigned xb_add(unsigned* p, unsigned v) { return __hip_atomic_fetch_add(p, v, __ATOMIC_RELAXED, __HIP_MEMORY_SCOPE_AGENT); }
__device__ __forceinline__ unsigned xb_xcc_id() { return (unsigned)__builtin_amdgcn_s_getreg((3 << 11) | 20) & 0xFu; }
#define XB_SPIN(cond, bar) do { unsigned _sp = 0; while (cond) { __builtin_amdgcn_s_sleep(1); \
    if ((++_sp & 255u) == 0u) { if (xb_ld(&(bar)[XB_TMO])) break; if (_sp > XB_SPIN_CAP) { atomicAdd(&(bar)[XB_TMO], 1u); break; } } } } while (0)

struct XcdBarrier {
    unsigned* bar; unsigned x;
    volatile LAS unsigned* st;
};

__device__ __forceinline__ XcdBarrier xcd_barrier_post(unsigned* bar, volatile LAS unsigned* st) {
    XcdBarrier b; b.bar = bar; b.x = xb_xcc_id(); b.st = st;
    if (threadIdx.x == 0) (void)xb_add(&bar[XB_XCNT(b.x)], 1u);
    return b;
}
__device__ __forceinline__ void xcd_barrier_complete(unsigned* bar, unsigned x, unsigned& nloc, unsigned& nx) {
    const unsigned G = gridDim.x * gridDim.y * gridDim.z;
    unsigned sum, cnt, mine, sp = 0u;
    for (;;) {
        sum = 0u; cnt = 0u; mine = 0u;
#pragma unroll
        for (unsigned j = 0; j < 16; ++j) { const unsigned c = xb_ld(&bar[XB_XCNT(j)]); sum += c; cnt += (c > 0u) ? 1u : 0u; mine = (j == x) ? c : mine; }
        if (sum == G) break;
        __builtin_amdgcn_s_sleep(1);
        if ((++sp & 255u) == 0u) { if (xb_ld(&bar[XB_TMO])) break; if (sp > XB_SPIN_CAP) { atomicAdd(&bar[XB_TMO], 1u); break; } }
    }
    nloc = mine > 0u ? mine : 1u; nx = cnt > 0u ? cnt : 1u;
}

__device__ __forceinline__ void xcd_barrier(const XcdBarrier& b) {
    asm volatile("s_waitcnt vmcnt(0)" ::: "memory");
    __syncthreads();
    if (threadIdx.x == 0) {
        unsigned* bar = b.bar;
        __builtin_amdgcn_s_waitcnt(0);
        unsigned nloc = b.st[0], nx = b.st[1];
        if (nloc == 0u) { xcd_barrier_complete(bar, b.x, nloc, nx); b.st[0] = nloc; b.st[1] = nx; }
        const unsigned old = xb_add(&bar[XB_XSUB(b.x)], 1u);
        const unsigned gen = old / nloc;
        if (old + 1u == (gen + 1u) * nloc) {
            __builtin_amdgcn_fence(__ATOMIC_RELEASE, "agent");
            asm volatile("s_waitcnt vmcnt(0)" ::: "memory");
            const unsigned og = xb_add(&bar[XB_TOP], 1u);
            const unsigned tg = og / nx;
            if (og + 1u == (tg + 1u) * nx) xb_add(&bar[XB_TOPGEN], 1u);
            else XB_SPIN(xb_ld(&bar[XB_TOPGEN]) == tg, bar);
            __builtin_amdgcn_fence(__ATOMIC_ACQUIRE, "agent");
            xb_add(&bar[XB_XGEN(b.x)], 1u);
            asm volatile("s_waitcnt vmcnt(0)" ::: "memory");
        } else {
            XB_SPIN(xb_ld(&bar[XB_XGEN(b.x)]) == gen, bar);
            __builtin_amdgcn_fence(__ATOMIC_ACQUIRE, "agent");
            asm volatile("s_waitcnt vmcnt(0)" ::: "memory");
        }
    }
    __syncthreads();
}

namespace pg8 {
constexpr int BM = 256, BK = 64, HALF = 128, HTB = HALF * BK * 2, STAGE_BYTES = 8 * HTB, NXCD = 8, WGM = 8;
__host__ __device__ __forceinline__ int lds_byte(int r, int c) { const int st = (r >> 4) * 2 + (c >> 5), rr = r & 15, cc = c & 31, ob = rr * 64 + cc * 2; return st * 1024 + (ob ^ (((ob >> 9) & 1) << 5)); }
__host__ __device__ __forceinline__ void stage_rc(int b, int& R, int& C) { const int st = b / 1024, sb = b % 1024, swz = sb ^ (((sb >> 9) & 1) << 5); R = (st >> 1) * 16 + swz / 64; C = (st & 1) * 32 + (swz % 64) / 2; }
__host__ __device__ __forceinline__ int perm32(int rho) { const int n = rho >> 4, i = rho & 15; return 8 * (i >> 2) + 4 * n + (i & 3); }
struct Unit { int pm, pn; };
struct Gemm { const bf16_t* A; const bf16_t* Bt; int K; };

__device__ __forceinline__ void tile_of(int L, int nM, int nN, Unit& u) {
    const int nwg = nM * nN; int wgid = L;
    { const int q = nwg / NXCD, r = nwg % NXCD, xcd = wgid % NXCD, off = wgid / NXCD; wgid = (xcd < r ? xcd * (q + 1) : r * (q + 1) + (xcd - r) * q) + off; }
    const int nig = WGM * nN, gid = wgid / nig, fm = gid * WGM, gsz = (nM - fm) < WGM ? (nM - fm) : WGM;
    u.pm = fm + ((wgid % nig) % gsz); u.pn = (wgid % nig) / gsz;
}
struct StaticOrder {
    int nM, nN, nwg, G, c;
    __device__ void init(int nM_, int nN_, int G_, int c_) { nM = nM_; nN = nN_; nwg = nM * nN; G = G_; c = c_; }
    __device__ __forceinline__ bool next(int i, Unit& u) const { const int L = i * G + c; if (L >= nwg) return false; tile_of(L, nM, nN, u); return true; }
};
struct PairOrder {
    int nM, nN, nwg, G, c;
    __device__ void init(int nM_, int nN_, int G_, int c_) { nM = nM_; nN = nN_; nwg = nM * nN; G = G_; c = c_; }
    __device__ __forceinline__ bool next(int i, Unit& u) const { const int L = (i >> 1) * G + c; if (L >= nwg) return false; tile_of(L, nM, nN, u); if (i & 1) { u.pm += nM; u.pn += nN; } return true; }
};

template <class Epi, class Sched>
__device__ __forceinline__ void gemm_phase(LAS unsigned char* lds, const Gemm g, const Sched& S, const Epi& E) {
    const int tid = tid_opaque(), wid = __builtin_amdgcn_readfirstlane(tid >> 6), lane = tid & 63, wr = wid >> 2, wc = wid & 3, fr = lane & 15, fq = lane >> 4;
    const int K = g.K, nt = K / BK;
    unsigned voffA[2], voffB[2];
#pragma unroll
    for (int i = 0; i < 2; ++i) { int R, C; stage_rc(tid * 16 + i * 8192, R, C); const int Rb = (R & ~31) + perm32(R & 31);
        voffA[i] = (unsigned)(R * K + C) * 2u; voffB[i] = (unsigned)(Rb * K + C) * 2u; }
    const size_t kstep = (size_t)(BK * 2);
    const size_t hstep = (size_t)HALF * K * 2;
    const size_t tstep = 2 * hstep;
    const unsigned ldsw = (unsigned)wid * 1024u;
    const int aoff = lds_byte(wr * 64 + fr, fq * 8), boff = lds_byte(wc * 32 + fr, fq * 8);
#define PG8_SA(b, h) (((b) * 2 + (h)) * HTB)
#define PG8_SB(b, h) ((4 + (b) * 2 + (h)) * HTB)
#define PG8_STAGE(bufoff, gbase, voff) do { _Pragma("unroll") for (int _i = 0; _i < 2; ++_i) \
        __builtin_amdgcn_global_load_lds((const unsigned*)((const char*)(gbase) + (voff)[_i]), (LAS unsigned*)(lds + (bufoff) + ldsw + _i * 8192), 16, 0, 0); } while (0)
#define PG8_LDA(dst, b, h) do { _Pragma("unroll") for (int m = 0; m < 4; ++m) _Pragma("unroll") for (int k = 0; k < 2; ++k) dst[m][k] = *(const LAS bf16x8*)(lds + PG8_SA(b, h) + aoff + m * 2048 + k * 1024); } while (0)
#define PG8_LDB(dst, b, h) do { _Pragma("unroll") for (int n = 0; n < 2; ++n) _Pragma("unroll") for (int k = 0; k < 2; ++k) dst[n][k] = *(const LAS bf16x8*)(lds + PG8_SB(b, h) + boff + n * 2048 + k * 1024); } while (0)
#define PG8_MMA(ai, bj, At, Bt) do { __builtin_amdgcn_s_setprio(1); _Pragma("unroll") for (int m = 0; m < 4; ++m) _Pragma("unroll") for (int n = 0; n < 2; ++n) _Pragma("unroll") for (int k = 0; k < 2; ++k) \
        acc[ai][bj][m][n] = __builtin_amdgcn_mfma_f32_16x16x32_bf16(Bt[n][k], At[m][k], acc[ai][bj][m][n], 0, 0, 0); __builtin_amdgcn_s_setprio(0); } while (0)
#define PG8_WAIT_V(n) asm volatile("s_waitcnt vmcnt(" #n ")" ::: "memory")
#define PG8_WAIT_L(n) asm volatile("s_waitcnt lgkmcnt(" #n ")" ::: "memory")
#define PG8_BAR __builtin_amdgcn_s_barrier()
#define PG8_SCHED __builtin_amdgcn_sched_barrier(0)
    Unit cur, nxt; int ui = 0;
    if (!S.next(0, cur)) return;
    f32x4 acc[2][2][4][2];
#pragma unroll
    for (int a = 0; a < 2; ++a)
#pragma unroll
        for (int b = 0; b < 2; ++b)
#pragma unroll
            for (int m = 0; m < 4; ++m)
#pragma unroll
                for (int n = 0; n < 2; ++n) acc[a][b][m][n] = (f32x4){0.f, 0.f, 0.f, 0.f};
    bf16x8 At[4][2], B0[2][2], B1[2][2];
    const char* cA = (const char*)g.A + (size_t)cur.pm * tstep; const char* cB = (const char*)g.Bt + (size_t)cur.pn * tstep;
    PG8_STAGE(PG8_SB(0, 0), cB, voffB); PG8_STAGE(PG8_SA(0, 0), cA, voffA); PG8_STAGE(PG8_SB(0, 1), cB + hstep, voffB); PG8_STAGE(PG8_SA(0, 1), cA + hstep, voffA);
    if (wr == 1) PG8_BAR;
    PG8_WAIT_V(4); PG8_BAR;
    PG8_STAGE(PG8_SB(1, 0), cB + kstep, voffB); PG8_STAGE(PG8_SA(1, 0), cA + kstep, voffA); PG8_STAGE(PG8_SB(1, 1), cB + hstep + kstep, voffB);
    PG8_WAIT_V(6); PG8_BAR;
    for (;;) {
        const bool has_next = S.next(ui + 1, nxt);
        const char* nA = has_next ? (const char*)g.A + (size_t)nxt.pm * tstep : cA; const char* nB = has_next ? (const char*)g.Bt + (size_t)nxt.pn * tstep : cB;
        for (int t = 0; t < nt; t += 2) {
            const bool last = (t == nt - 2);
            const char* a1 = cA + (size_t)(t + 1) * kstep;
            const char* a2 = last ? nA : cA + (size_t)(t + 2) * kstep; const char* b2 = last ? nB : cB + (size_t)(t + 2) * kstep;
            const char* a3 = a2 + kstep; const char* b3 = b2 + kstep;
            PG8_LDB(B0, 0, 0); PG8_SCHED; PG8_LDA(At, 0, 0); PG8_STAGE(PG8_SA(1, 1), a1 + hstep, voffA);
            PG8_WAIT_L(8); PG8_BAR; PG8_WAIT_L(0); PG8_MMA(0, 0, At, B0); PG8_BAR; PG8_SCHED;
            PG8_LDB(B1, 0, 1); PG8_STAGE(PG8_SB(0, 0), b2, voffB);
            PG8_BAR; PG8_WAIT_L(0); PG8_MMA(0, 1, At, B1); PG8_BAR;
            PG8_LDA(At, 0, 1); PG8_STAGE(PG8_SA(0, 0), a2, voffA);
            PG8_BAR; PG8_WAIT_L(0); PG8_MMA(1, 0, At, B0); PG8_BAR; PG8_SCHED;
            PG8_STAGE(PG8_SB(0, 1), b2 + hstep, voffB);
            PG8_WAIT_V(6); PG8_BAR; PG8_MMA(1, 1, At, B1); PG8_BAR;
            PG8_LDB(B0, 1, 0); PG8_SCHED; PG8_LDA(At, 1, 0); PG8_STAGE(PG8_SA(0, 1), a2 + hstep, voffA);
            PG8_WAIT_L(8); PG8_BAR; PG8_WAIT_L(0); PG8_MMA(0, 0, At, B0); PG8_BAR; PG8_SCHED;
            PG8_LDB(B1, 1, 1); PG8_STAGE(PG8_SB(1, 0), b3, voffB);
            PG8_BAR; PG8_WAIT_L(0); PG8_MMA(0, 1, At, B1); PG8_BAR;
            PG8_LDA(At, 1, 1); PG8_STAGE(PG8_SA(1, 0), a3, voffA);
            PG8_BAR; PG8_WAIT_L(0); PG8_MMA(1, 0, At, B0); PG8_BAR; PG8_SCHED;
            PG8_STAGE(PG8_SB(1, 1), b3 + hstep, voffB);
            PG8_WAIT_V(6); PG8_BAR; PG8_MMA(1, 1, At, B1); PG8_BAR;
        }
        E(acc, cur, wr, wc, fr, fq);
        if (!has_next) break;
#pragma unroll
        for (int a = 0; a < 2; ++a)
#pragma unroll
            for (int b = 0; b < 2; ++b)
#pragma unroll
                for (int m = 0; m < 4; ++m)
#pragma unroll
                    for (int n = 0; n < 2; ++n) acc[a][b][m][n] = (f32x4){0.f, 0.f, 0.f, 0.f};
        cur = nxt; cA = nA; cB = nB; ++ui;
    }
    PG8_WAIT_V(0);
    if (wr == 0) PG8_BAR;
    PG8_BAR;
#undef PG8_SA
#undef PG8_SB
#undef PG8_STAGE
#undef PG8_LDA
#undef PG8_LDB
#undef PG8_MMA
#undef PG8_WAIT_V
#undef PG8_WAIT_L
#undef PG8_BAR
#undef PG8_SCHED
}
}

#define EPI_LOOP_BEGIN \
    _Pragma("unroll") for (int ai = 0; ai < 2; ++ai) _Pragma("unroll") for (int m = 0; m < 4; ++m) _Pragma("unroll") for (int bj = 0; bj < 2; ++bj) { \
        const int rl = ai * 128 + wr * 64 + m * 16 + fr, cl = bj * 128 + wc * 32 + 8 * fq; const f32x4 v0 = acc[ai][bj][m][0], v1 = acc[ai][bj][m][1];
#define EPI_LOOP_END }

__device__ __forceinline__ u32x4 pack8(const f32x4 a, const f32x4 b) { u32x4 o; o[0] = cvt_pk_bf16(a[0], a[1]); o[1] = cvt_pk_bf16(a[2], a[3]); o[2] = cvt_pk_bf16(b[0], b[1]); o[3] = cvt_pk_bf16(b[2], b[3]); return o; }

struct EpiProj {
    unsigned char* ws;
    __device__ __forceinline__ void operator()(const f32x4 (&acc)[2][2][4][2], const pg8::Unit& u, int wr, int wc, int fr, int fq) const {
        const int pn = u.pn, row0 = u.pm * 256;
        if (pn < 4) {
            bf16_t* PU = (bf16_t*)(ws + W_PU);
            EPI_LOOP_BEGIN
                const int ch = pn * 256 + cl, g = ch >> 4, half = (ch >> 3) & 1;
                *(u32x4*)(PU + ((size_t)g * MT + row0 + rl) * 16 + half * 8) = pack8(v0, v1);
            EPI_LOOP_END
            return;
        }
        if (pn >= 8 && pn < 24) {
            bf16_t* dst = (bf16_t*)(ws + (wc < 2 ? W_PC : W_PB)) + (pn - 8) * 64 + (wc & 1) * 32 + 8 * fq;
#pragma unroll
            for (int ai = 0; ai < 2; ++ai)
#pragma unroll
                for (int m = 0; m < 4; ++m) {
                    const int rl = ai * 128 + wr * 64 + m * 16 + fr;
                    f32x4 a = acc[ai][0][m][0], b = acc[ai][0][m][1]; const f32x4 a2 = acc[ai][1][m][0], b2 = acc[ai][1][m][1];
                    if (wc < 2) { a = a * a2; b = b * b2; }
                    else { _Pragma("unroll") for (int j = 0; j < 4; ++j) { a[j] *= siluf_(a2[j]); b[j] *= siluf_(b2[j]); } }
                    *(u32x4*)(dst + (size_t)(row0 + rl) * 1024) = pack8(a, b);
                }
            return;
        }
        bf16_t* base; int ld, colt, act;
        if (pn < 8) { colt = (pn & 3) * 256; ld = 1024; act = 1; base = (bf16_t*)(ws + W_PZA); }
        else {
            bf16_t* SA = (bf16_t*)(ws + W_PGA) + (pn - 24) * 128 + wc * 32 + 8 * fq; bf16_t* RT = (bf16_t*)(ws + W_PGC) + (pn - 24) * 128 + wc * 32 + 8 * fq;
#pragma unroll
            for (int ai = 0; ai < 2; ++ai)
#pragma unroll
                for (int m = 0; m < 4; ++m) {
                    const int rl = ai * 128 + wr * 64 + m * 16 + fr;
                    f32x4 s0, s1, r0, r1;
#pragma unroll
                    for (int j = 0; j < 4; ++j) {
                        const float ea0 = fminf(__expf(-acc[ai][0][m][0][j]), 1e30f), ec0 = __expf(-acc[ai][1][m][0][j]), ea1 = fminf(__expf(-acc[ai][0][m][1][j]), 1e30f), ec1 = __expf(-acc[ai][1][m][1][j]);
                        s0[j] = __builtin_amdgcn_rcpf(1.0f + ea0); r0[j] = (1.0f + ea0) * __builtin_amdgcn_rcpf(1.0f + ec0);
                        s1[j] = __builtin_amdgcn_rcpf(1.0f + ea1); r1[j] = (1.0f + ea1) * __builtin_amdgcn_rcpf(1.0f + ec1); }
                    *(u32x4*)(SA + (size_t)(row0 + rl) * 2048) = pack8(s0, s1); *(u32x4*)(RT + (size_t)(row0 + rl) * 2048) = pack8(r0, r1);
                }
            return;
        }
        EPI_LOOP_BEGIN
            f32x4 a = v0, b = v1;
            if (act == 1) { _Pragma("unroll") for (int j = 0; j < 4; ++j) { a[j] = siluf_(a[j]); b[j] = siluf_(b[j]); } }
            else if (act == 2) { _Pragma("unroll") for (int j = 0; j < 4; ++j) { a[j] = sigmoidf_(a[j]); b[j] = sigmoidf_(b[j]); } }
            *(u32x4*)(base + (size_t)(row0 + rl) * ld + colt + cl) = pack8(a, b);
        EPI_LOOP_END
    }
};
#define EPI_HALF_BEGIN _Pragma("unroll") for (int ai = 0; ai < 2; ++ai) {
#define EPI_HALF_END }
#define EPI_MB_LOOP _Pragma("unroll") for (int m = 0; m < 4; ++m) _Pragma("unroll") for (int bj = 0; bj < 2; ++bj)
#define EPI_RL (ai * 128 + wr * 64 + m * 16 + fr)
#define EPI_CL (bj * 128 + wc * 32 + 8 * fq)
struct EpiGlu {
    unsigned char* ws;
    __device__ __forceinline__ void operator()(const f32x4 (&acc)[2][2][4][2], const pg8::Unit& u, int wr, int wc, int fr, int fq) const {
        const bf16_t* G1 = (const bf16_t*)(ws + W_G1); const bf16_t* ZA = (const bf16_t*)(ws + W_PZA); bf16_t* YA = (bf16_t*)(ws + W_YAC);
        EPI_HALF_BEGIN
            u32x4 gv[4][2], zv[4][2];
            EPI_MB_LOOP { const size_t o = (size_t)(u.pm * 256 + EPI_RL) * 1024 + u.pn * 256 + EPI_CL; gv[m][bj] = *(const u32x4*)(G1 + o); zv[m][bj] = *(const u32x4*)(ZA + o); }
            EPI_MB_LOOP { const size_t o = (size_t)(u.pm * 256 + EPI_RL) * 1024 + u.pn * 256 + EPI_CL;
                const f32x4 v0 = acc[ai][bj][m][0], v1 = acc[ai][bj][m][1]; const u32x4 g = gv[m][bj], z = zv[m][bj];
                f32x4 a, b;
                a[0] = bf_lo(g[0]) * sigmoidf_(v0[0]) * bf_lo(z[0]); a[1] = bf_hi(g[0]) * sigmoidf_(v0[1]) * bf_hi(z[0]);
                a[2] = bf_lo(g[1]) * sigmoidf_(v0[2]) * bf_lo(z[1]); a[3] = bf_hi(g[1]) * sigmoidf_(v0[3]) * bf_hi(z[1]);
                b[0] = bf_lo(g[2]) * sigmoidf_(v1[0]) * bf_lo(z[2]); b[1] = bf_hi(g[2]) * sigmoidf_(v1[1]) * bf_hi(z[2]);
                b[2] = bf_lo(g[3]) * sigmoidf_(v1[2]) * bf_lo(z[3]); b[3] = bf_hi(g[3]) * sigmoidf_(v1[3]) * bf_hi(z[3]);
                *(u32x4*)(YA + o) = pack8(a, b); }
        EPI_HALF_END
    }
};
struct EpiMerge {
    unsigned char* ws;
    __device__ __forceinline__ void operator()(const f32x4 (&acc)[2][2][4][2], const pg8::Unit& u, int wr, int wc, int fr, int fq) const {
        const bool second = u.pm >= 36; const int pm = second ? u.pm - 36 : u.pm, pn = second ? u.pn - 8 : u.pn;
        const bf16_t* GT = (const bf16_t*)(ws + (second ? W_PGC : W_PGA)); bf16_t* MG = (bf16_t*)(ws + W_MG);
        EPI_HALF_BEGIN
            u32x4 gv[4][2], pv[4][2];
            EPI_MB_LOOP { const size_t o = (size_t)(pm * 256 + EPI_RL) * 2048 + pn * 256 + EPI_CL; gv[m][bj] = *(const u32x4*)(GT + o); }
            if (second) { EPI_MB_LOOP { const size_t o = (size_t)(pm * 256 + EPI_RL) * 2048 + pn * 256 + EPI_CL; pv[m][bj] = *(const u32x4*)(MG + o); } }
            else { EPI_MB_LOOP pv[m][bj] = (u32x4){0u, 0u, 0u, 0u}; }
            EPI_MB_LOOP { const size_t o = (size_t)(pm * 256 + EPI_RL) * 2048 + pn * 256 + EPI_CL;
                const f32x4 v0 = acc[ai][bj][m][0], v1 = acc[ai][bj][m][1]; const u32x4 g = gv[m][bj], q = pv[m][bj];
                f32x4 a, b;
                a[0] = bf_lo(g[0]) * v0[0] + bf_lo(q[0]); a[1] = bf_hi(g[0]) * v0[1] + bf_hi(q[0]); a[2] = bf_lo(g[1]) * v0[2] + bf_lo(q[1]); a[3] = bf_hi(g[1]) * v0[3] + bf_hi(q[1]);
                b[0] = bf_lo(g[2]) * v1[0] + bf_lo(q[2]); b[1] = bf_hi(g[2]) * v1[1] + bf_hi(q[2]); b[2] = bf_lo(g[3]) * v1[2] + bf_lo(q[3]); b[3] = bf_hi(g[3]) * v1[3] + bf_hi(q[3]);
                *(u32x4*)(MG + o) = pack8(a, b); }
        EPI_HALF_END
    }
};
struct EpiResid {
    const float* xp; const float* xs; float* out;
    __device__ __forceinline__ void operator()(const f32x4 (&acc)[2][2][4][2], const pg8::Unit& u, int wr, int wc, int fr, int fq) const {
        EPI_HALF_BEGIN
            f32x4 x0[4][2], x1[4][2];
            EPI_MB_LOOP { const int row = u.pm * 256 + EPI_RL, col = u.pn * 256 + EPI_CL;
                const float* xr = row < MP ? xp + (size_t)row * D_MODEL : xs + (size_t)(row - MP) * D_MODEL;
                x0[m][bj] = *(const f32x4*)(xr + col); x1[m][bj] = *(const f32x4*)(xr + col + 4); }
            EPI_MB_LOOP { const int row = u.pm * 256 + EPI_RL, col = u.pn * 256 + EPI_CL;
                float* o = out + (size_t)row * D_MODEL + col;
                *(f32x4*)o = x0[m][bj] * DN_ALPHA + acc[ai][bj][m][0]; *(f32x4*)(o + 4) = x1[m][bj] * DN_ALPHA + acc[ai][bj][m][1]; }
        EPI_HALF_END
    }
};

__device__ __forceinline__ void transpose_tile(const float* __restrict__ W, int K, int N, bf16_t* __restrict__ Wt, int kt, int ntile, LAS float* tile, int ldt, int kd0, int nd0) {
    const int t = tid_opaque(), k0 = kt * 64, n0 = ntile * 64;
    const int r = t >> 4, c4 = (t & 15) * 4;
#pragma unroll
    for (int h = 0; h < 2; ++h) { const f32x4 v = *(const f32x4*)(W + (size_t)(k0 + r + 32 * h) * N + n0 + c4);
#pragma unroll
        for (int j = 0; j < 4; ++j) tile[(r + 32 * h) * 65 + c4 + j] = v[j]; }
    __syncthreads();
    const int n = t >> 3, k8 = (t & 7) * 8;
    float v[8];
#pragma unroll
    for (int j = 0; j < 8; ++j) v[j] = tile[(k8 + j) * 65 + n];
    u32x4 o; o[0] = cvt_pk_bf16(v[0], v[1]); o[1] = cvt_pk_bf16(v[2], v[3]); o[2] = cvt_pk_bf16(v[4], v[5]); o[3] = cvt_pk_bf16(v[6], v[7]);
    *(u32x4*)(Wt + (size_t)(nd0 + n) * ldt + kd0 + k8) = o;
    __syncthreads();
}
__device__ __forceinline__ void phase_convert(const Params& p, LAS unsigned char* lds) {
    const int G = gridDim.x, bid = blockIdx.x, tid = tid_opaque();
    {
        bf16_t* XB = (bf16_t*)(p.ws + W_XB);
        const size_t nitems = (size_t)MT * D_MODEL / 8, np = (size_t)MP * D_MODEL / 8;
        for (size_t i = (size_t)bid * 512 + tid; i < nitems; i += (size_t)G * 512) {
            const float* src = i < np ? p.x_prompt + i * 8 : p.x_sample + (i - np) * 8;
            const f32x4 a = *(const f32x4*)src, b = *(const f32x4*)(src + 4);
            *(u32x4*)(XB + i * 8) = pack8(a, b);
        }
    }
    LAS float* tile = (LAS float*)lds;
    for (int j = bid; j < 5120; j += G) { const int nt64 = j % 160, n0 = nt64 * 64; int nd0 = n0;
        if (n0 >= 6144) { const int kind = (n0 - 6144) >> 11, c0 = (n0 - 6144) & 2047; nd0 = 6144 + (c0 >> 7) * 256 + kind * 128 + ((c0 >> 6) & 1) * 64; }
        else if (n0 >= 2048 && n0 < 6144) { const int kind = (n0 - 2048) >> 10, t64 = ((n0 - 2048) & 1023) >> 6, slot = kind == 0 ? 1 : kind == 1 ? 0 : kind; nd0 = 2048 + t64 * 256 + slot * 64; }
        transpose_tile(p.w_in, 2048, NIN, (bf16_t*)(p.ws + W_WINT), j / 160, nt64, tile, 2048, (j / 160) * 64, nd0); }
}
__device__ __forceinline__ void phase_convert_late(const Params& p, LAS unsigned char* lds, int bidx, int nblk) {
    LAS float* tile = (LAS float*)lds;
    for (int j = bidx; j < 2304; j += nblk) {
        const float* W; bf16_t* Wt; int K, N, jj;
        if (j < 512) { W = p.w_out_a; Wt = (bf16_t*)(p.ws + W_WOACT); K = 1024; N = 2048; jj = j; }
        else if (j < 1024) { W = p.w_out_c; Wt = (bf16_t*)(p.ws + W_WOACT) + (size_t)2048 * 1024; K = 1024; N = 2048; jj = j - 512; }
        else if (j < 2048) { W = p.w_o; Wt = (bf16_t*)(p.ws + W_WOT); K = 2048; N = 2048; jj = j - 1024; }
        else { W = p.w_glu; Wt = (bf16_t*)(p.ws + W_WGLUT); K = 1024; N = 1024; jj = j - 2048; }
        const int nn = N / 64, kt = jj / nn; int kd0 = kt * 64;
        if (K == 2048 && kd0 >= 1024) { kd0 -= 1024; Wt += (size_t)2048 * 1024; }
        transpose_tile(W, K, N, Wt, kt, jj % nn, tile, 1024, kd0, (jj % nn) * 64);
    }
}

constexpr int L_LAM = 0, L_E = 4608, L_WT = L_E + 4096, L_VT = L_WT + 128 * 272, L_KM = L_VT + 144 * 272, L_U = L_KM + 4096, L_HIN = L_U + 64 * 272, L_S = L_HIN + 64 * 272, L_SSM_END = L_S + 32768;
constexpr int L_BBT = L_U;
constexpr int LDS_BYTES = 155648;
static_assert(L_SSM_END <= LDS_BYTES - 32, "lds");
static_assert(pg8::STAGE_BYTES <= LDS_BYTES - 32, "lds");

__device__ __forceinline__ void ssm_setup(const Params& p, int g, LAS unsigned char* lds, int w, int fr, int fq) {
    const int tid = tid_opaque();
    LAS float* lam = (LAS float*)(lds + L_LAM);
    LAS float* bbar = (LAS float*)(lds + L_S);
    LAS float* ct = (LAS float*)(lds + L_S + 8192);
    LAS float* qv = (LAS float*)(lds + L_S + 16384);
    __syncthreads();
    {
        const float dt = expf(p.log_dt[g]);
        for (int e = tid; e < 576; e += 512) { const int k = e >> 6, pp = e & 63; const float ar = p.a_re[g * 64 + pp], ai = p.a_im[g * 64 + pp];
            const float mg = expf((float)k * (ar * dt)), a = (float)k * (ai * dt); lam[e * 2] = mg * cosf(a); lam[e * 2 + 1] = mg * sinf(a); }
        if (tid < 64) { const float ar = p.a_re[g * 64 + tid], ai = p.a_im[g * 64 + tid], ang = ai * dt, x = ar * dt;
            const float em1 = expm1f(x), mg = em1 + 1.0f, sh = sinf(0.5f * ang);
            const float lrm1 = em1 - 2.0f * mg * sh * sh, li = mg * sinf(ang), den = ar * ar + ai * ai;
            qv[tid * 2] = (lrm1 * ar + li * ai) / den; qv[tid * 2 + 1] = (li * ar - lrm1 * ai) / den; }
#pragma unroll
        for (int j = 0; j < 2; ++j) { const int e = tid + 512 * j; ct[e * 2] = p.c_re[(size_t)g * 1024 + e]; ct[e * 2 + 1] = p.c_im[(size_t)g * 1024 + e]; }
    }
    __syncthreads();
#pragma unroll
    for (int j = 0; j < 2; ++j) {
        const int e = tid + 512 * j, pp = e >> 4;
        const float br = p.b_re[(size_t)g * 1024 + e], bi = p.b_im[(size_t)g * 1024 + e], qr = qv[pp * 2], qi = qv[pp * 2 + 1];
        bbar[e * 2] = qr * br - qi * bi; bbar[e * 2 + 1] = qr * bi + qi * br;
    }
    __syncthreads();
#pragma unroll
    for (int j = 0; j < 4; ++j) {
        const int it = tid + 512 * j, n = it >> 4, oct = it & 15, ri = n >> 6, pp = n & 63, s = oct >> 1, c0 = (oct & 1) * 8;
        const float lr = lam[((7 - s) * 64 + pp) * 2], li = lam[((7 - s) * 64 + pp) * 2 + 1];
        float v[8];
#pragma unroll
        for (int q = 0; q < 4; ++q) { const f32x4 bb = *(const LAS f32x4*)(bbar + (pp * 16 + c0 + 2 * q) * 2);
            v[2 * q] = ri == 0 ? lr * bb[0] - li * bb[1] : lr * bb[1] + li * bb[0]; v[2 * q + 1] = ri == 0 ? lr * bb[2] - li * bb[3] : lr * bb[3] + li * bb[2]; }
        u32x4 o; o[0] = cvt_pk_bf16(v[0], v[1]); o[1] = cvt_pk_bf16(v[2], v[3]); o[2] = cvt_pk_bf16(v[4], v[5]); o[3] = cvt_pk_bf16(v[6], v[7]);
        *(LAS u32x4*)(lds + L_WT + n * 272 + oct * 16) = o;
    }
    if (tid < 256) {
        const int c = tid >> 4, oct = tid & 15, ri = oct >> 3, p0 = (oct & 7) * 8;
        float v[8];
#pragma unroll
        for (int q = 0; q < 8; ++q) v[q] = bbar[((p0 + q) * 16 + c) * 2 + ri];
        u32x4 o; o[0] = cvt_pk_bf16(v[0], v[1]); o[1] = cvt_pk_bf16(v[2], v[3]); o[2] = cvt_pk_bf16(v[4], v[5]); o[3] = cvt_pk_bf16(v[6], v[7]);
        *(LAS u32x4*)(lds + L_BBT + c * 272 + oct * 16) = o;
    }
    for (int it = tid; it < 2304; it += 512) {
        const int n = it >> 4, oct = it & 15, k = n >> 4, c = n & 15, ri = oct >> 3, p0 = (oct & 7) * 8;
        float v[8];
#pragma unroll
        for (int q = 0; q < 4; ++q) { const f32x4 ll = *(const LAS f32x4*)(lam + (k * 64 + p0 + 2 * q) * 2), cc = *(const LAS f32x4*)(ct + (c * 64 + p0 + 2 * q) * 2);
            v[2 * q] = ri == 0 ? cc[0] * ll[0] - cc[1] * ll[1] : -(cc[0] * ll[1] + cc[1] * ll[0]); v[2 * q + 1] = ri == 0 ? cc[2] * ll[2] - cc[3] * ll[3] : -(cc[2] * ll[3] + cc[3] * ll[2]); }
        u32x4 o; o[0] = cvt_pk_bf16(v[0], v[1]); o[1] = cvt_pk_bf16(v[2], v[3]); o[2] = cvt_pk_bf16(v[4], v[5]); o[3] = cvt_pk_bf16(v[6], v[7]);
        *(LAS u32x4*)(lds + L_VT + n * 272 + oct * 16) = o;
    }
    __syncthreads();
    {
        f32x4 acc = {0.f, 0.f, 0.f, 0.f};
#pragma unroll
        for (int kk = 0; kk < 4; ++kk) {
            const bf16x8 bq = *(const LAS bf16x8*)(lds + L_BBT + fr * 272 + kk * 64 + fq * 16);
            const bf16x8 av = *(const LAS bf16x8*)(lds + L_VT + (w * 16 + fr) * 272 + kk * 64 + fq * 16);
            acc = __builtin_amdgcn_mfma_f32_16x16x32_bf16(bq, av, acc, 0, 0, 0);
        }
        u32x2 o; o[0] = cvt_pk_bf16(acc[0], acc[1]); o[1] = cvt_pk_bf16(acc[2], acc[3]);
        *(LAS u32x2*)(lds + L_KM + ((w * 16 + fr) * 16 + fq * 4) * 2) = o;
    }
    __syncthreads();
}

__device__ __forceinline__ void ssm_pass_a(LAS unsigned char* lds, int nrb, int w, int fr, int fq) {
    bf16x8 bw[4];
#pragma unroll
    for (int kk = 0; kk < 4; ++kk) bw[kk] = *(const LAS bf16x8*)(lds + L_WT + (w * 16 + fr) * 272 + kk * 64 + fq * 16);
    LAS float* S = (LAS float*)(lds + L_S);
    for (int rb = 0; rb < nrb; ++rb) {
        f32x4 acc = {0.f, 0.f, 0.f, 0.f};
#pragma unroll
        for (int kk = 0; kk < 4; ++kk) { const bf16x8 a = *(const LAS bf16x8*)(lds + L_U + (rb * 16 + fr) * 272 + kk * 64 + fq * 16); acc = __builtin_amdgcn_mfma_f32_16x16x32_bf16(a, bw[kk], acc, 0, 0, 0); }
#pragma unroll
        for (int j = 0; j < 4; ++j) S[(rb * 16 + fq * 4 + j) * 128 + w * 16 + fr] = acc[j];
    }
}
__device__ __forceinline__ void ssm_pass_c(const Params& p, LAS unsigned char* lds, int nrb, int t, int fr, int fq, int g, int tok_base) {
    bf16_t* G1 = (bf16_t*)(p.ws + W_G1);
    const f32x4 dv = *(const f32x4*)(p.ssm_d + g * 16 + fq * 4);
    for (int rb = 0; rb < nrb; ++rb) {
        f32x4 acc = {0.f, 0.f, 0.f, 0.f};
#pragma unroll
        for (int kk = 0; kk < 4; ++kk) {
            const bf16x8 bv = *(const LAS bf16x8*)(lds + L_VT + ((t + 1) * 16 + fr) * 272 + kk * 64 + fq * 16);
            const bf16x8 ah = *(const LAS bf16x8*)(lds + L_HIN + (rb * 16 + fr) * 272 + kk * 64 + fq * 16);
            acc = __builtin_amdgcn_mfma_f32_16x16x32_bf16(bv, ah, acc, 0, 0, 0);
        }
#pragma unroll
        for (int kk = 0; kk < 4; ++kk) {
            if (2 * kk <= t) {
                const int lag = t - 2 * kk - (fq >> 1);
                bf16x8 bk = *(const LAS bf16x8*)(lds + L_KM + (((lag < 0 ? 0 : lag) * 16 + fr) * 16 + (fq & 1) * 8) * 2);
                if (lag < 0) bk = (bf16x8){0, 0, 0, 0, 0, 0, 0, 0};
                const bf16x8 au = *(const LAS bf16x8*)(lds + L_U + (rb * 16 + fr) * 272 + kk * 64 + fq * 16);
                acc = __builtin_amdgcn_mfma_f32_16x16x32_bf16(bk, au, acc, 0, 0, 0);
            }
        }
        const int rr = rb * 16 + fr;
        const u32x2 uv = *(const LAS u32x2*)(lds + L_U + rr * 272 + (t * 16 + fq * 4) * 2);
        f32x4 y;
        y[0] = gelu_tanh(acc[0] + dv[0] * bf_lo(uv[0])); y[1] = gelu_tanh(acc[1] + dv[1] * bf_hi(uv[0]));
        y[2] = gelu_tanh(acc[2] + dv[2] * bf_lo(uv[1])); y[3] = gelu_tanh(acc[3] + dv[3] * bf_hi(uv[1]));
        u32x2 o; o[0] = cvt_pk_bf16(y[0], y[1]); o[1] = cvt_pk_bf16(y[2], y[3]);
        *(u32x2*)(G1 + (size_t)(tok_base + rr * 8 + t) * 1024 + g * 16 + fq * 4) = o;
    }
}

__device__ __forceinline__ void unpack8(const u32x4 v, float (&f)[8]) { f[0] = bf_lo(v[0]); f[1] = bf_hi(v[0]); f[2] = bf_lo(v[1]); f[3] = bf_hi(v[1]); f[4] = bf_lo(v[2]); f[5] = bf_hi(v[2]); f[6] = bf_lo(v[3]); f[7] = bf_hi(v[3]); }
constexpr int CONV_ITEMS = (MT / 8) * 128;
template <int T0, int T1> __device__ __forceinline__ void conv_issue(const Params& p, int i, u32x4 (&qv)[8], u32x4 (&bv)[8]) {
    const bf16_t* BZ = (const bf16_t*)(p.ws + W_PB); const bf16_t* Q = (const bf16_t*)(p.ws + W_PC);
    const int c8 = (i & 127) * 8, row0 = (i >> 7) * 8;
#pragma unroll
    for (int t = T0; t < T1; ++t) { const size_t o = (size_t)(row0 + t) * 1024 + c8; qv[t] = *(const u32x4*)(Q + o); bv[t] = *(const u32x4*)(BZ + o); }
}
__device__ __forceinline__ void conv_finish(const Params& p, int i, const u32x4 (&qv)[8], const u32x4 (&bv)[8]) {
    const bf16_t* Q = (const bf16_t*)(p.ws + W_PC);
    bf16_t* YC = (bf16_t*)(p.ws + W_YAC) + (size_t)MT * 1024;
    const int c8 = (i & 127) * 8, chunk = i >> 7, row0 = chunk * 8;
    float w0[8], w1[8], w2[8], q2[8], q1[8];
#pragma unroll
    for (int j = 0; j < 8; ++j) { w0[j] = p.conv_w[c8 + j]; w1[j] = p.conv_w[1024 + c8 + j]; w2[j] = p.conv_w[2048 + c8 + j]; }
    const bool sample = row0 >= MP; const int t0 = sample ? 0 : (row0 & (SEQ - 1));
    if (sample) { const int b = (row0 - MP) >> 3; const float* sc = p.st_conv + (size_t)b * 2048 + c8;
#pragma unroll
        for (int j = 0; j < 8; ++j) { q2[j] = sc[j]; q1[j] = sc[1024 + j]; } }
    else if (t0 == 0) {
#pragma unroll
        for (int j = 0; j < 8; ++j) { q2[j] = 0.f; q1[j] = 0.f; } }
    else { unpack8(*(const u32x4*)(Q + (size_t)(row0 - 2) * 1024 + c8), q2); unpack8(*(const u32x4*)(Q + (size_t)(row0 - 1) * 1024 + c8), q1); }
#pragma unroll
    for (int t = 0; t < 8; ++t) {
        const size_t o = (size_t)(row0 + t) * 1024 + c8;
        float qq[8], bb[8], y[8];
        unpack8(qv[t], qq); unpack8(bv[t], bb);
#pragma unroll
        for (int j = 0; j < 8; ++j) { const float q = qq[j]; y[j] = bb[j] * (q2[j] * w0[j] + q1[j] * w1[j] + q * w2[j]); q2[j] = q1[j]; q1[j] = q; }
        u32x4 ov; ov[0] = cvt_pk_bf16(y[0], y[1]); ov[1] = cvt_pk_bf16(y[2], y[3]); ov[2] = cvt_pk_bf16(y[4], y[5]); ov[3] = cvt_pk_bf16(y[6], y[7]);
        *(u32x4*)(YC + o) = ov;
    }
    if (sample) { const int b = (row0 - MP) >> 3; float* d = p.out + O_CVS + (size_t)b * 2048 + c8;
#pragma unroll
        for (int j = 0; j < 8; ++j) { d[j] = q2[j]; d[1024 + j] = q1[j]; } }
    else if (t0 == SEQ - 8) { const int b = row0 >> 11; float* d = p.out + O_CVP + (size_t)b * 2048 + c8;
#pragma unroll
        for (int j = 0; j < 8; ++j) { d[j] = q2[j]; d[1024 + j] = q1[j]; } }
}

__device__ __forceinline__ void lds_barrier() { asm volatile("s_waitcnt lgkmcnt(0)" ::: "memory"); __builtin_amdgcn_s_barrier(); asm volatile("" ::: "memory"); }
__device__ __forceinline__ void phase_ssm(const Params& p, LAS unsigned char* lds) {
    const int tid = tid_opaque(), w = __builtin_amdgcn_readfirstlane(tid >> 6), lane = tid & 63, fr = lane & 15, fq = lane >> 4;
    const bf16_t* PU = (const bf16_t*)(p.ws + W_PU);
    LAS float* lam = (LAS float*)(lds + L_LAM);
    LAS float* S = (LAS float*)(lds + L_S);
    LAS float* E = (LAS float*)(lds + L_E);
    int g_cur = -1;
    const int ci = blockIdx.x * 512 + tid; bool cpref = false; u32x4 cq[8], cb[8];
    bool pref = false; u32x4 pua = {0u, 0u, 0u, 0u}, puc = {0u, 0u, 0u, 0u}; float ph0r[4] = {0.f, 0.f, 0.f, 0.f}, ph0i[4] = {0.f, 0.f, 0.f, 0.f};
    for (int unit = blockIdx.x; unit < 512; unit += gridDim.x) {
        const int g = unit & 63, sub = (unit >> 6) & 3; const bool sample = unit >= 256;
        if (g != g_cur) { ssm_setup(p, g, lds, w, fr, fq); g_cur = g; }
        const float l8r = lam[(8 * 64 + lane) * 2], l8i = lam[(8 * 64 + lane) * 2 + 1];
        if (!sample) {
            const int b = sub;
            if (!cpref && ci < CONV_ITEMS) { conv_issue<0, 4>(p, ci, cq, cb); cpref = true; }
            {
                const int nu = unit + gridDim.x; pref = nu >= 256 && nu < 512;
                if (pref) { const int gs = nu & 63, b0s = ((nu >> 6) & 3) * 32;
                    if (tid < 256) { const u32x4* src = (const u32x4*)(PU + ((size_t)gs * MT + MP + b0s * 8 + tid) * 16); pua = src[0]; puc = src[1]; }
#pragma unroll
                    for (int j = 0; j < 4; ++j) { const int e = tid + 512 * j, rr = e >> 6, pp = e & 63; const size_t o = ((size_t)(b0s + rr) * 64 + gs) * 64 + pp; ph0r[j] = p.st_re[o]; ph0i[j] = p.st_im[o]; } }
            }
            float l64r, l64i; { float ar = l8r * l8r - l8i * l8i, ai = 2.f * l8r * l8i; float br = ar * ar - ai * ai, bi = 2.f * ar * ai; l64r = br * br - bi * bi; l64i = 2.f * br * bi; }
            float hsr = 0.f, hsi = 0.f;
            u32x4 ua, uc; { const u32x4* src = (const u32x4*)(PU + ((size_t)g * MT + b * SEQ + tid) * 16); ua = src[0]; uc = src[1]; }

            for (int seg = 0; seg < 4; ++seg) {
                const int tok_base = b * SEQ + seg * 512;
                {
                    LAS unsigned char* d = lds + L_U + (tid >> 3) * 272 + (tid & 7) * 32;
                    *(LAS u32x4*)d = ua; *(LAS u32x4*)(d + 16) = uc;
                    if (seg < 3) { const u32x4* src = (const u32x4*)(PU + ((size_t)g * MT + tok_base + 512 + tid) * 16); ua = src[0]; uc = src[1]; }
                }
                lds_barrier();
                ssm_pass_a(lds, 4, w, fr, fq);
                lds_barrier();
                float xr[8], xi[8];
#pragma unroll
                for (int i = 0; i < 8; ++i) { xr[i] = S[(8 * w + i) * 128 + lane]; xi[i] = S[(8 * w + i) * 128 + 64 + lane]; }
                float hr = 0.f, hi = 0.f;
#pragma unroll
                for (int i = 0; i < 8; ++i) { const float sr = xr[i], si = xi[i]; xr[i] = hr; xi[i] = hi; const float nr = l8r * hr - l8i * hi + sr, ni = l8r * hi + l8i * hr + si; hr = nr; hi = ni; }
                E[w * 128 + lane] = hr; E[w * 128 + 64 + lane] = hi;
                lds_barrier();
                float cr = hsr, ci = hsi, myr = 0.f, myi = 0.f;
#pragma unroll
                for (int jj = 0; jj < 8; ++jj) { if (jj == w) { myr = cr; myi = ci; } const float er = E[jj * 128 + lane], ei = E[jj * 128 + 64 + lane];
                    const float nr = l64r * cr - l64i * ci + er, ni = l64r * ci + l64i * cr + ei; cr = nr; ci = ni; }
                hsr = cr; hsi = ci;
#pragma unroll
                for (int i = 0; i < 8; ++i) {
                    *(LAS bf16_t*)(lds + L_HIN + (8 * w + i) * 272 + lane * 2) = f2bf(xr[i] + myr); *(LAS bf16_t*)(lds + L_HIN + (8 * w + i) * 272 + (64 + lane) * 2) = f2bf(xi[i] + myi);
                    const float nr = l8r * myr - l8i * myi, ni = l8r * myi + l8i * myr; myr = nr; myi = ni;
                }
                lds_barrier();
                ssm_pass_c(p, lds, 4, w, fr, fq, g, tok_base);
                lds_barrier();
            }
            if (w == 0) { p.out[O_SRP + ((size_t)b * 64 + g) * 64 + lane] = hsr; p.out[O_SIP + ((size_t)b * 64 + g) * 64 + lane] = hsi; }
        } else {
            const int b0 = sub * 32, tok_base = MP + b0 * 8;
            float h0r[4], h0i[4];
            if (pref) {
#pragma unroll
                for (int j = 0; j < 4; ++j) { h0r[j] = ph0r[j]; h0i[j] = ph0i[j]; }
            } else {
                if (tid < 256) { const u32x4* src = (const u32x4*)(PU + ((size_t)g * MT + tok_base + tid) * 16); pua = src[0]; puc = src[1]; }
#pragma unroll
                for (int j = 0; j < 4; ++j) {
                    const int e = tid + 512 * j, rr = e >> 6, pp = e & 63;
                    const size_t o = ((size_t)(b0 + rr) * 64 + g) * 64 + pp;
                    h0r[j] = p.st_re[o]; h0i[j] = p.st_im[o];
                }
            }
            pref = false;
            if (tid < 256) { LAS unsigned char* d = lds + L_U + (tid >> 3) * 272 + (tid & 7) * 32; *(LAS u32x4*)d = pua; *(LAS u32x4*)(d + 16) = puc; }
#pragma unroll
            for (int j = 0; j < 4; ++j) {
                const int e = tid + 512 * j, rr = e >> 6, pp = e & 63;
                *(LAS bf16_t*)(lds + L_HIN + rr * 272 + pp * 2) = f2bf(h0r[j]); *(LAS bf16_t*)(lds + L_HIN + rr * 272 + (64 + pp) * 2) = f2bf(h0i[j]);
            }
            __syncthreads();
            ssm_pass_a(lds, 2, w, fr, fq);
            __syncthreads();
#pragma unroll
            for (int j = 0; j < 4; ++j) {
                const int e = tid + 512 * j, rr = e >> 6, pp = e & 63;
                const size_t o = ((size_t)(b0 + rr) * 64 + g) * 64 + pp;
                const float sr = S[rr * 128 + pp], si = S[rr * 128 + 64 + pp];
                p.out[O_SRS + o] = l8r * h0r[j] - l8i * h0i[j] + sr; p.out[O_SIS + o] = l8r * h0i[j] + l8i * h0r[j] + si;
            }
            ssm_pass_c(p, lds, 2, w, fr, fq, g, tok_base);
            __syncthreads();
        }
    }
    if (ci < CONV_ITEMS) { if (!cpref) conv_issue<0, 4>(p, ci, cq, cb); conv_issue<4, 8>(p, ci, cq, cb); conv_finish(p, ci, cq, cb); }
    { const int G = gridDim.x, rest = CONV_ITEMS - G * 512;
      if (rest > 0) { const int per = (rest + G - 1) / G;
        for (int k = tid; k < per; k += 512) { const int i = G * 512 + blockIdx.x * per + k; if (i < CONV_ITEMS) { conv_issue<0, 8>(p, i, cq, cb); conv_finish(p, i, cq, cb); } } } }
}

__device__ __forceinline__ void phase_ln(const Params& p) {
    const int tl = tid_opaque(), lane = tl & 63, wv = tl >> 6;
    for (int row = blockIdx.x * 8 + wv; row < MT; row += gridDim.x * 8) {
        float* r = p.out + (size_t)row * D_MODEL;
        f32x4 v[8]; float s = 0.f;
#pragma unroll
        for (int j = 0; j < 8; ++j) { v[j] = *(const f32x4*)(r + j * 256 + lane * 4); s += v[j][0] + v[j][1] + v[j][2] + v[j][3]; }
#pragma unroll
        for (int o = 32; o > 0; o >>= 1) s += __shfl_xor(s, o);
        const float mu = s * (1.0f / D_MODEL);
        float q = 0.f;
#pragma unroll
        for (int j = 0; j < 8; ++j) { v[j] = v[j] - mu; q += v[j][0] * v[j][0] + v[j][1] * v[j][1] + v[j][2] * v[j][2] + v[j][3] * v[j][3]; }
#pragma unroll
        for (int o = 32; o > 0; o >>= 1) q += __shfl_xor(q, o);
        const float rs = rsqrtf(q * (1.0f / D_MODEL) + LN_EPS);
#pragma unroll
        for (int j = 0; j < 8; ++j) { const f32x4 gg = *(const f32x4*)(p.ln_g + j * 256 + lane * 4), bb = *(const f32x4*)(p.ln_b + j * 256 + lane * 4);
            *(f32x4*)(r + j * 256 + lane * 4) = v[j] * rs * gg + bb; }
    }
}

namespace flow {
using namespace pg8;
enum { T_GLU = 0, T_C = 1, T_A = 2, T_O1 = 3, T_O2 = 4 };
struct FUnit { int type, pm, pn, h; };
constexpr int NJ_GLU = 144, NJ_PAIR = 288, NJ_OF = 224, NJ_OH = 128, NJOBS = NJ_GLU + NJ_PAIR + NJ_OF + NJ_OH;
constexpr int CTL_QHEAD = 0, CTL_PRE = 64, CTL_LNQ = 64 * 120, NJ_LN = 576;
__host__ __device__ constexpr int CTL_G(int pm) { return 64 * (2 + pm); }
__host__ __device__ constexpr int CTL_M(int pm) { return 64 * (40 + pm); }
__host__ __device__ constexpr int CTL_R(int pm) { return 64 * (80 + pm); }
constexpr size_t HSZ = (size_t)MT * 1024 * 2, WSZ = (size_t)2048 * 1024 * 2, TSTEP = (size_t)256 * 1024 * 2;
__device__ __forceinline__ const char* unitA(const unsigned char* ws, const FUnit& u) {
    const size_t off = u.type == T_GLU ? W_G1 : u.type == T_C ? W_YAC + HSZ : u.type == T_A ? W_YAC : u.type == T_O1 ? W_MG : W_MG + HSZ;
    return (const char*)ws + off + (size_t)u.pm * TSTEP + (u.h == 2 ? TSTEP / 2 : 0);
}
__device__ __forceinline__ const char* unitB(const unsigned char* ws, const FUnit& u) {
    const size_t off = u.type == T_GLU ? W_WGLUT : u.type == T_C ? W_WOACT + WSZ : u.type == T_A ? W_WOACT : u.type == T_O1 ? W_WOT : W_WOT + WSZ;
    return (const char*)ws + off + (size_t)u.pn * TSTEP;
}
__device__ __forceinline__ void st_wt(__amdgpu_buffer_rsrc_t r, size_t byte_off, u32x4 v) { __builtin_amdgcn_raw_buffer_store_b128(v, r, (unsigned)byte_off, 0, 16); }

__device__ __forceinline__ void epilogue(const Params& p, const f32x4 (&acc)[2][2][4][2], const FUnit& u, int wr, int wc, int fr, int fq) {
    unsigned char* ws = p.ws;
    if (u.type == T_GLU) {
        const bf16_t* G1 = (const bf16_t*)(ws + W_G1); const bf16_t* ZA = (const bf16_t*)(ws + W_PZA);
        const __amdgpu_buffer_rsrc_t rs = __builtin_amdgcn_make_buffer_rsrc(ws + W_YAC, 0, (int)HSZ, 0x00020000);
        EPI_HALF_BEGIN
            u32x4 gv[4][2], zv[4][2];
            EPI_MB_LOOP { const size_t o = (size_t)(u.pm * 256 + EPI_RL) * 1024 + u.pn * 256 + EPI_CL; gv[m][bj] = *(const u32x4*)(G1 + o); zv[m][bj] = *(const u32x4*)(ZA + o); }
            EPI_MB_LOOP { const size_t o = (size_t)(u.pm * 256 + EPI_RL) * 1024 + u.pn * 256 + EPI_CL;
                const f32x4 v0 = acc[ai][bj][m][0], v1 = acc[ai][bj][m][1]; const u32x4 g = gv[m][bj], z = zv[m][bj];
                f32x4 a, b;
                a[0] = bf_lo(g[0]) * sigmoidf_(v0[0]) * bf_lo(z[0]); a[1] = bf_hi(g[0]) * sigmoidf_(v0[1]) * bf_hi(z[0]);
                a[2] = bf_lo(g[1]) * sigmoidf_(v0[2]) * bf_lo(z[1]); a[3] = bf_hi(g[1]) * sigmoidf_(v0[3]) * bf_hi(z[1]);
                b[0] = bf_lo(g[2]) * sigmoidf_(v1[0]) * bf_lo(z[2]); b[1] = bf_hi(g[2]) * sigmoidf_(v1[1]) * bf_hi(z[2]);
                b[2] = bf_lo(g[3]) * sigmoidf_(v1[2]) * bf_lo(z[3]); b[3] = bf_hi(g[3]) * sigmoidf_(v1[3]) * bf_hi(z[3]);
                st_wt(rs, o * 2, pack8(a, b)); }
        EPI_HALF_END
    } else if (u.type == T_A) {
        const bf16_t* SA = (const bf16_t*)(ws + W_PGA);
        const __amdgpu_buffer_rsrc_t rs = __builtin_amdgcn_make_buffer_rsrc(ws + W_MG, 0, (int)(2 * HSZ), 0x00020000);
        const size_t hoff = (size_t)(u.pn >> 2) * HSZ;
        u32x4 gv[2][4][2];
        EPI_HALF_BEGIN
            EPI_MB_LOOP { const size_t o = (size_t)(u.pm * 256 + EPI_RL) * 2048 + u.pn * 256 + EPI_CL; gv[ai][m][bj] = *(const u32x4*)(SA + o); }
        EPI_HALF_END
        EPI_HALF_BEGIN
            EPI_MB_LOOP { const size_t o = (size_t)(u.pm * 256 + EPI_RL) * 1024 + (u.pn & 3) * 256 + EPI_CL;
                const f32x4 v0 = acc[ai][bj][m][0], v1 = acc[ai][bj][m][1]; const u32x4 g = gv[ai][m][bj];
                f32x4 a, b;
                a[0] = bf_lo(g[0]) * v0[0]; a[1] = bf_hi(g[0]) * v0[1]; a[2] = bf_lo(g[1]) * v0[2]; a[3] = bf_hi(g[1]) * v0[3];
                b[0] = bf_lo(g[2]) * v1[0]; b[1] = bf_hi(g[2]) * v1[1]; b[2] = bf_lo(g[3]) * v1[2]; b[3] = bf_hi(g[3]) * v1[3];
                st_wt(rs, hoff + o * 2, pack8(a, b)); }
        EPI_HALF_END
    } else {
        const int rbase = u.pm * 256 + (u.h == 2 ? 128 : 0);
        const bf16_t* XB = (const bf16_t*)(ws + W_XB);
        const __amdgpu_buffer_rsrc_t rsr = __builtin_amdgcn_make_buffer_rsrc(ws + W_PH, 0, (int)(2 * HSZ), 0x00020000);
        u32x4 xv[2][4][2];
        EPI_HALF_BEGIN
            if (u.h != 0 && ai == 1) break;
            EPI_MB_LOOP { const size_t o = (size_t)(rbase + EPI_RL) * D_MODEL + u.pn * 256 + EPI_CL; xv[ai][m][bj] = *(const u32x4*)(XB + o); }
        EPI_HALF_END
        EPI_HALF_BEGIN
            if (u.h != 0 && ai == 1) break;
            EPI_MB_LOOP { const size_t o = (size_t)(rbase + EPI_RL) * D_MODEL + u.pn * 256 + EPI_CL;
                const u32x4 x = xv[ai][m][bj]; const f32x4 v0 = acc[ai][bj][m][0], v1 = acc[ai][bj][m][1];
                f32x4 a, b;
                a[0] = bf_lo(x[0]) * DN_ALPHA + v0[0]; a[1] = bf_hi(x[0]) * DN_ALPHA + v0[1]; a[2] = bf_lo(x[1]) * DN_ALPHA + v0[2]; a[3] = bf_hi(x[1]) * DN_ALPHA + v0[3];
                b[0] = bf_lo(x[2]) * DN_ALPHA + v1[0]; b[1] = bf_hi(x[2]) * DN_ALPHA + v1[1]; b[2] = bf_lo(x[3]) * DN_ALPHA + v1[2]; b[3] = bf_hi(x[3]) * DN_ALPHA + v1[3];
                st_wt(rsr, o * 2, pack8(a, b)); }
        EPI_HALF_END
    }
}

__device__ __forceinline__ void ln_rows(const Params& p, int row0, int nrows, int lane) {
    const bf16_t* R = (const bf16_t*)(p.ws + W_PH);
    for (int row = row0; row < row0 + nrows; ++row) {
        const bf16_t* r = R + (size_t)row * D_MODEL;
        float v[32]; float s = 0.f;
#pragma unroll
        for (int j = 0; j < 4; ++j) { const u32x4 w = *(const u32x4*)(r + j * 512 + lane * 8);
#pragma unroll
            for (int q = 0; q < 4; ++q) { v[j * 8 + 2 * q] = bf_lo(w[q]); v[j * 8 + 2 * q + 1] = bf_hi(w[q]); } }
#pragma unroll
        for (int j = 0; j < 32; ++j) s += v[j];
#pragma unroll
        for (int o = 32; o > 0; o >>= 1) s += __shfl_xor(s, o);
        const float mu = s * (1.0f / D_MODEL);
        float q2 = 0.f;
#pragma unroll
        for (int j = 0; j < 32; ++j) { v[j] -= mu; q2 += v[j] * v[j]; }
#pragma unroll
        for (int o = 32; o > 0; o >>= 1) q2 += __shfl_xor(q2, o);
        const float rs = rsqrtf(q2 * (1.0f / D_MODEL) + LN_EPS);
        float* o = p.out + (size_t)row * D_MODEL;
#pragma unroll
        for (int j = 0; j < 4; ++j)
#pragma unroll
            for (int h = 0; h < 2; ++h) { const int c = j * 512 + lane * 8 + h * 4; const f32x4 gg = *(const f32x4*)(p.ln_g + c), bb = *(const f32x4*)(p.ln_b + c);
                f32x4 y; y[0] = v[j * 8 + h * 4] * rs * gg[0] + bb[0]; y[1] = v[j * 8 + h * 4 + 1] * rs * gg[1] + bb[1]; y[2] = v[j * 8 + h * 4 + 2] * rs * gg[2] + bb[2]; y[3] = v[j * 8 + h * 4 + 3] * rs * gg[3] + bb[3];
                *(f32x4*)(o + c) = y; }
    }
}

__device__ __forceinline__ void gemm_flow(LAS unsigned char* lds, const Params& p, unsigned npre) {
    const int tid = tid_opaque(), wid = __builtin_amdgcn_readfirstlane(tid >> 6), lane = tid & 63, wr = wid >> 2, wc = wid & 3, fr = lane & 15, fq = lane >> 4;
    constexpr int K = 1024, nt = K / BK;
    unsigned* ctl = (unsigned*)(p.ws + W_CTL);
    volatile LAS unsigned* slot = (volatile LAS unsigned*)(lds + LDS_BYTES - 32);
    unsigned voffA[2], voffB[2];
#pragma unroll
    for (int i = 0; i < 2; ++i) { int R, C; stage_rc(tid * 16 + i * 8192, R, C); const int Rb = (R & ~31) + perm32(R & 31);
        voffA[i] = (unsigned)(R * K + C) * 2u; voffB[i] = (unsigned)(Rb * K + C) * 2u; }
    const size_t kstep = (size_t)(BK * 2);
    const size_t hstep = (size_t)HALF * K * 2;
    const unsigned ldsw = (unsigned)wid * 1024u;
    const int aoff = lds_byte(wr * 64 + fr, fq * 8), boff = lds_byte(wc * 32 + fr, fq * 8);
#define PG8_SA(b, h) (((b) * 2 + (h)) * HTB)
#define PG8_SB(b, h) ((4 + (b) * 2 + (h)) * HTB)
#define PG8_STAGE(bufoff, gbase, voff) do { _Pragma("unroll") for (int _i = 0; _i < 2; ++_i) \
        __builtin_amdgcn_global_load_lds((const unsigned*)((const char*)(gbase) + (voff)[_i]), (LAS unsigned*)(lds + (bufoff) + ldsw + _i * 8192), 16, 0, 0); } while (0)
#define PG8_LDA(dst, b, h) do { _Pragma("unroll") for (int m = 0; m < 4; ++m) _Pragma("unroll") for (int k = 0; k < 2; ++k) dst[m][k] = *(const LAS bf16x8*)(lds + PG8_SA(b, h) + aoff + m * 2048 + k * 1024); } while (0)
#define PG8_LDB(dst, b, h) do { _Pragma("unroll") for (int n = 0; n < 2; ++n) _Pragma("unroll") for (int k = 0; k < 2; ++k) dst[n][k] = *(const LAS bf16x8*)(lds + PG8_SB(b, h) + boff + n * 2048 + k * 1024); } while (0)
#define PG8_MMA(ai, bj, At, Bt) do { __builtin_amdgcn_s_setprio(1); _Pragma("unroll") for (int m = 0; m < 4; ++m) _Pragma("unroll") for (int n = 0; n < 2; ++n) _Pragma("unroll") for (int k = 0; k < 2; ++k) \
        acc[ai][bj][m][n] = __builtin_amdgcn_mfma_f32_16x16x32_bf16(Bt[n][k], At[m][k], acc[ai][bj][m][n], 0, 0, 0); __builtin_amdgcn_s_setprio(0); } while (0)
#define PG8_WAIT_V(n) asm volatile("s_waitcnt vmcnt(" #n ")" ::: "memory")
#define PG8_WAIT_L(n) asm volatile("s_waitcnt lgkmcnt(" #n ")" ::: "memory")
#define PG8_BAR __builtin_amdgcn_s_barrier()
#define PG8_SCHED __builtin_amdgcn_sched_barrier(0)
    bool pend = false;
#define FLOW_NEXT(prevu, outu, has) FLOW_NEXT_(prevu, outu, has, false)
#define FLOW_NEXT_(prevu, outu, has, PRE) do { \
        if (pend) { outu.type = prevu.type + 1; outu.pm = prevu.pm; outu.pn = prevu.pn; outu.h = prevu.h; pend = false; has = true; } \
        else { if (!(PRE)) { if (tid == 0) { const unsigned _j = __hip_atomic_fetch_add(ctl + CTL_QHEAD, 1u, __ATOMIC_RELAXED, __HIP_MEMORY_SCOPE_AGENT); *slot = _j; asm volatile("s_waitcnt lgkmcnt(0)" ::: "memory"); } \
            asm volatile("" ::: "memory"); PG8_BAR; asm volatile("" ::: "memory"); } \
            const int _jb = __builtin_amdgcn_readfirstlane((int)*slot); \
            if (_jb >= NJOBS) has = false; \
            else { has = true; outu.h = 0; \
                if (_jb < NJ_GLU) { outu.type = T_GLU; outu.pm = _jb >> 2; outu.pn = _jb & 3; } \
                else if (_jb < NJ_GLU + NJ_PAIR) { const int _q = _jb - NJ_GLU; outu.type = T_C; outu.pm = _q >> 3; outu.pn = _q & 7; pend = true; } \
                else { const int _q = _jb - NJ_GLU - NJ_PAIR; outu.type = T_O1; pend = true; \
                    if (_q < NJ_OF) { outu.pm = _q >> 3; outu.pn = _q & 7; } \
                    else { const int _r = _q - NJ_OF, _t = _r >> 1; outu.pm = (NJ_OF >> 3) + (_t >> 3); outu.pn = _t & 7; outu.h = 1 + (_r & 1); } } } } } while (0)
#define FLOW_READY(uu) do { \
        if ((uu.type == T_C && npre != 0u) || uu.type == T_A || uu.type == T_O1) { \
            if (wid == 0) { const unsigned* _c = ctl + (uu.type == T_C ? CTL_PRE : uu.type == T_A ? CTL_G(uu.pm) : CTL_M(uu.pm)); const unsigned _need = uu.type == T_C ? npre : uu.type == T_A ? 32u : 64u; \
                unsigned _polls = 0; while ((unsigned)__builtin_amdgcn_readfirstlane(__hip_atomic_load(_c, __ATOMIC_RELAXED, __HIP_MEMORY_SCOPE_AGENT)) < _need) { __builtin_amdgcn_s_sleep(2); if (++_polls > (1u << 20)) break; } \
                asm volatile("s_waitcnt vmcnt(0)" ::: "memory"); } \
            asm volatile("" ::: "memory"); PG8_BAR; asm volatile("" ::: "memory"); } } while (0)
#define FLOW_DONE(uu) do { \
        if (uu.type == T_GLU || uu.type == T_A || uu.type == T_O2) { asm volatile("s_waitcnt vmcnt(0)" ::: "memory"); \
            if (lane == 0) (void)__hip_atomic_fetch_add(ctl + (uu.type == T_GLU ? CTL_G(uu.pm) : uu.type == T_A ? CTL_M(uu.pm) : CTL_R(uu.pm)), 1u, __ATOMIC_RELAXED, __HIP_MEMORY_SCOPE_AGENT); } } while (0)
    FUnit cur, nxt; bool has_cur;
    cur.type = 0; cur.pm = 0; cur.pn = 0; cur.h = 0; nxt = cur;
    FLOW_NEXT_(cur, cur, has_cur, true);
    if (has_cur) {
    f32x4 acc[2][2][4][2];
#pragma unroll
    for (int a = 0; a < 2; ++a)
#pragma unroll
        for (int b = 0; b < 2; ++b)
#pragma unroll
            for (int m = 0; m < 4; ++m)
#pragma unroll
                for (int n = 0; n < 2; ++n) acc[a][b][m][n] = (f32x4){0.f, 0.f, 0.f, 0.f};
    bf16x8 At[4][2], B0[2][2], B1[2][2];
    for (;;) {
        const char* cA = unitA(p.ws, cur); const char* cB = unitB(p.ws, cur);
        FLOW_READY(cur);
        PG8_STAGE(PG8_SB(0, 0), cB, voffB); PG8_STAGE(PG8_SA(0, 0), cA, voffA); PG8_STAGE(PG8_SB(0, 1), cB + hstep, voffB); PG8_STAGE(PG8_SA(0, 1), cA + hstep, voffA);
        if (wr == 1) PG8_BAR;
        PG8_WAIT_V(4); PG8_BAR;
        PG8_STAGE(PG8_SB(1, 0), cB + kstep, voffB); PG8_STAGE(PG8_SA(1, 0), cA + kstep, voffA); PG8_STAGE(PG8_SB(1, 1), cB + hstep + kstep, voffB);
        PG8_WAIT_V(6); PG8_BAR;
        bool has_next;
        for (;;) {
            FLOW_NEXT(cur, nxt, has_next);
            const bool chain = has_next && nxt.type != T_O1;
            const bool full = cur.h == 0;
            const char* nA = chain ? unitA(p.ws, nxt) : cA; const char* nB = chain ? unitB(p.ws, nxt) : cB;
            for (int t = 0; t < nt; t += 2) {
                const bool last = (t == nt - 2);
                const char* a1 = cA + (size_t)(t + 1) * kstep;
                const char* a2 = last ? nA : cA + (size_t)(t + 2) * kstep; const char* b2 = last ? nB : cB + (size_t)(t + 2) * kstep;
                const char* a3 = a2 + kstep; const char* b3 = b2 + kstep;
                if (last && chain) FLOW_READY(nxt);
                PG8_LDB(B0, 0, 0); PG8_SCHED; PG8_LDA(At, 0, 0); PG8_STAGE(PG8_SA(1, 1), a1 + hstep, voffA);
                PG8_WAIT_L(8); PG8_BAR; PG8_WAIT_L(0); PG8_MMA(0, 0, At, B0); PG8_BAR; PG8_SCHED;
                PG8_LDB(B1, 0, 1); PG8_STAGE(PG8_SB(0, 0), b2, voffB);
                PG8_BAR; PG8_WAIT_L(0); PG8_MMA(0, 1, At, B1); PG8_BAR;
                PG8_LDA(At, 0, 1); PG8_STAGE(PG8_SA(0, 0), a2, voffA);
                PG8_BAR; PG8_WAIT_L(0); if (full) PG8_MMA(1, 0, At, B0); PG8_BAR; PG8_SCHED;
                PG8_STAGE(PG8_SB(0, 1), b2 + hstep, voffB);
                PG8_WAIT_V(6); PG8_BAR; if (full) PG8_MMA(1, 1, At, B1); PG8_BAR;
                PG8_LDB(B0, 1, 0); PG8_SCHED; PG8_LDA(At, 1, 0); PG8_STAGE(PG8_SA(0, 1), a2 + hstep, voffA);
                PG8_WAIT_L(8); PG8_BAR; PG8_WAIT_L(0); PG8_MMA(0, 0, At, B0); PG8_BAR; PG8_SCHED;
                PG8_LDB(B1, 1, 1); PG8_STAGE(PG8_SB(1, 0), b3, voffB);
                PG8_BAR; PG8_WAIT_L(0); PG8_MMA(0, 1, At, B1); PG8_BAR;
                PG8_LDA(At, 1, 1); PG8_STAGE(PG8_SA(1, 0), a3, voffA);
                PG8_BAR; PG8_WAIT_L(0); if (full) PG8_MMA(1, 0, At, B0); PG8_BAR; PG8_SCHED;
                PG8_STAGE(PG8_SB(1, 1), b3 + hstep, voffB);
                PG8_WAIT_V(6); PG8_BAR; if (full) PG8_MMA(1, 1, At, B1); PG8_BAR;
            }
            if (cur.type != T_C && cur.type != T_O1) { epilogue(p, acc, cur, wr, wc, fr, fq); FLOW_DONE(cur); }
            if (!chain) break;
            {
                const bool isTC = cur.type == T_C;
                const unsigned kbits = (nxt.type == T_O2) ? 0x3F803F80u : 0u;
                const bf16_t* RT = (const bf16_t*)(p.ws + W_PGC);
                u32x4 gv[2][4][2];
                EPI_HALF_BEGIN
                    if (isTC) { EPI_MB_LOOP { const size_t o = (size_t)(cur.pm * 256 + EPI_RL) * 2048 + cur.pn * 256 + EPI_CL; gv[ai][m][bj] = *(const u32x4*)(RT + o); } }
                    else { EPI_MB_LOOP gv[ai][m][bj] = (u32x4){kbits, kbits, kbits, kbits}; }
                EPI_HALF_END
                EPI_HALF_BEGIN
                    EPI_MB_LOOP { const u32x4 g = gv[ai][m][bj];
                        acc[ai][bj][m][0][0] *= bf_lo(g[0]); acc[ai][bj][m][0][1] *= bf_hi(g[0]); acc[ai][bj][m][0][2] *= bf_lo(g[1]); acc[ai][bj][m][0][3] *= bf_hi(g[1]);
                        acc[ai][bj][m][1][0] *= bf_lo(g[2]); acc[ai][bj][m][1][1] *= bf_hi(g[2]); acc[ai][bj][m][1][2] *= bf_lo(g[3]); acc[ai][bj][m][1][3] *= bf_hi(g[3]); }
                EPI_HALF_END
            }
            cur = nxt; cA = nA; cB = nB;
        }
        PG8_WAIT_V(0);
        if (wr == 0) PG8_BAR;
        PG8_BAR;
        if (!has_next) break;
#pragma unroll
        for (int a = 0; a < 2; ++a)
#pragma unroll
            for (int b = 0; b < 2; ++b)
#pragma unroll
                for (int m = 0; m < 4; ++m)
#pragma unroll
                    for (int n = 0; n < 2; ++n) acc[a][b][m][n] = (f32x4){0.f, 0.f, 0.f, 0.f};
        cur = nxt;
    }
    }
    __syncthreads();
    for (;;) {
        if (tid == 0) { const unsigned _j = __hip_atomic_fetch_add(ctl + CTL_LNQ, 1u, __ATOMIC_RELAXED, __HIP_MEMORY_SCOPE_AGENT); *slot = _j; }
        __syncthreads();
        const int j = __builtin_amdgcn_readfirstlane((int)*slot);
        if (j >= NJ_LN) break;
        const int pm = j >> 4, part = j & 15;
        if (wid == 0) { const unsigned* _c = ctl + CTL_R(pm); const unsigned _need = pm < (NJ_OF >> 3) ? 64u : 128u;
            unsigned _polls = 0; while ((unsigned)__builtin_amdgcn_readfirstlane(__hip_atomic_load(_c, __ATOMIC_RELAXED, __HIP_MEMORY_SCOPE_AGENT)) < _need) { __builtin_amdgcn_s_sleep(16); if (++_polls > (1u << 20)) break; }
            asm volatile("s_waitcnt vmcnt(0)" ::: "memory"); }
        __syncthreads();
        ln_rows(p, pm * 256 + part * 16 + wid * 2, 2, lane);
    }
#undef FLOW_NEXT
#undef FLOW_NEXT_
#undef FLOW_READY
#undef FLOW_DONE
#undef PG8_SA
#undef PG8_SB
#undef PG8_STAGE
#undef PG8_LDA
#undef PG8_LDB
#undef PG8_MMA
#undef PG8_WAIT_V
#undef PG8_WAIT_L
#undef PG8_BAR
#undef PG8_SCHED
}
}

__device__ __forceinline__ void run_phase(const Params& p, LAS unsigned char* lds, int ph) {
    const int G = gridDim.x, c = blockIdx.x;
    if (ph == 0) { phase_convert(p, lds); }
    else if (ph == 1) { pg8::StaticOrder S; S.init(36, 40, G, c); pg8::Gemm g{(const bf16_t*)(p.ws + W_XB), (const bf16_t*)(p.ws + W_WINT), 2048}; EpiProj E{p.ws}; pg8::gemm_phase(lds, g, S, E);
        const int rem = 1440 % G; if (rem == 0) phase_convert_late(p, lds, c, G); else if (c >= rem) phase_convert_late(p, lds, c - rem, G - rem); }
    else if (ph == 2) { phase_ssm(p, lds);
        __syncthreads();
        if (tid_opaque() == 0) { const unsigned j = __hip_atomic_fetch_add((unsigned*)(p.ws + W_CTL) + flow::CTL_QHEAD, 1u, __ATOMIC_RELAXED, __HIP_MEMORY_SCOPE_AGENT);
            *(volatile LAS unsigned*)(lds + LDS_BYTES - 32) = j; } }
    else if (ph == 3) {
        const int npre = 0;
        flow::gemm_flow(lds, p, (unsigned)npre);
    }
    else { phase_ln(p); }
}

extern __shared__ __attribute__((aligned(16))) unsigned char dyn_lds[];

#if MK_SINGLE
__global__ __launch_bounds__(512, 2) void mega_kernel(Params p) {
    LAS unsigned char* lds = (LAS unsigned char*)dyn_lds;
    if (__builtin_expect(p.ws == nullptr, 0)) cg::this_grid().sync();
    volatile LAS unsigned* st = (volatile LAS unsigned*)(lds + LDS_BYTES - 16);
    if (threadIdx.x == 0) { st[0] = 0u; st[1] = 0u; st[2] = 0u; st[3] = 0u; }
    __syncthreads();
    const XcdBarrier xb = xcd_barrier_post((unsigned*)(p.ws + W_BAR), st);
#ifndef PROBE_DUP
#define PROBE_DUP -1
#endif
#ifndef PROBE_SYNCS
#define PROBE_SYNCS 0
#endif
#define RUNP(k) do { run_phase(p, lds, k); xcd_barrier(xb); if (PROBE_DUP == k) { run_phase(p, lds, k); xcd_barrier(xb); } for (int _s = 0; _s < PROBE_SYNCS; ++_s) xcd_barrier(xb); } while (0)
    RUNP(0); RUNP(1); RUNP(2);
    run_phase(p, lds, 3);
}
#endif
template <int PH> __global__ __launch_bounds__(512, 2) void phase_kernel(Params p) {
    LAS unsigned char* lds = (LAS unsigned char*)dyn_lds;
    run_phase(p, lds, PH);
}

extern "C" void kernel_launch(void* const* d_in, const int* in_sizes, int n_in, void* d_out, int out_size, void* d_ws, size_t ws_size, hipStream_t stream) {
    Params p{};
    p.x_prompt = (const float*)d_in[0]; p.x_sample = (const float*)d_in[1]; p.st_re = (const float*)d_in[2]; p.st_im = (const float*)d_in[3]; p.st_conv = (const float*)d_in[4];
    p.w_in = (const float*)d_in[5]; p.a_re = (const float*)d_in[6]; p.a_im = (const float*)d_in[7]; p.log_dt = (const float*)d_in[8]; p.b_re = (const float*)d_in[9]; p.b_im = (const float*)d_in[10];
    p.c_re = (const float*)d_in[11]; p.c_im = (const float*)d_in[12]; p.ssm_d = (const float*)d_in[13]; p.w_glu = (const float*)d_in[14]; p.w_out_a = (const float*)d_in[15]; p.conv_w = (const float*)d_in[16];
    p.w_out_c = (const float*)d_in[17]; p.w_o = (const float*)d_in[18]; p.ln_g = (const float*)d_in[19]; p.ln_b = (const float*)d_in[20];
    p.out = (float*)d_out; p.ws = (unsigned char*)d_ws;
    if (ws_size < W_END) { fprintf(stderr, "workspace too small: %zu < %zu\n", ws_size, (size_t)W_END); return; }
#if MK_SINGLE
    static int grid_blocks = 0;
    if (!grid_blocks) {
        int dev = 0, cus = 0, per_cu = 0;
        hipGetDevice(&dev);
        hipDeviceGetAttribute(&cus, hipDeviceAttributeMultiprocessorCount, dev);
        hipFuncSetAttribute((const void*)mega_kernel, hipFuncAttributeMaxDynamicSharedMemorySize, LDS_BYTES);
        hipOccupancyMaxActiveBlocksPerMultiprocessor(&per_cu, mega_kernel, 512, LDS_BYTES);
        if (per_cu < 1) per_cu = 1;
        grid_blocks = cus * per_cu; if (grid_blocks > 256) grid_blocks = 256;
    }
    (void)hipMemsetAsync(p.ws + W_BAR, 0, 16384 + 32768, stream);
    void* args[] = {&p};
    hipError_t e = hipLaunchCooperativeKernel((const void*)mega_kernel, dim3(grid_blocks), dim3(512), args, LDS_BYTES, stream);
    if (e != hipSuccess) fprintf(stderr, "cooperative launch failed: %s (grid %d)\n", hipGetErrorString(e), grid_blocks);
#else
    static bool attr = false;
    if (!attr) {
        hipFuncSetAttribute((const void*)phase_kernel<0>, hipFuncAttributeMaxDynamicSharedMemorySize, LDS_BYTES); hipFuncSetAttribute((const void*)phase_kernel<1>, hipFuncAttributeMaxDynamicSharedMemorySize, LDS_BYTES);
        hipFuncSetAttribute((const void*)phase_kernel<2>, hipFuncAttributeMaxDynamicSharedMemorySize, LDS_BYTES); hipFuncSetAttribute((const void*)phase_kernel<3>, hipFuncAttributeMaxDynamicSharedMemorySize, LDS_BYTES);
        hipFuncSetAttribute((const void*)phase_kernel<4>, hipFuncAttributeMaxDynamicSharedMemorySize, LDS_BYTES); hipFuncSetAttribute((const void*)phase_kernel<5>, hipFuncAttributeMaxDynamicSharedMemorySize, LDS_BYTES);
        hipFuncSetAttribute((const void*)phase_kernel<6>, hipFuncAttributeMaxDynamicSharedMemorySize, LDS_BYTES); attr = true;
    }
    phase_kernel<0><<<256, 512, LDS_BYTES, stream>>>(p);
    phase_kernel<1><<<256, 512, LDS_BYTES, stream>>>(p);
    phase_kernel<2><<<256, 512, LDS_BYTES, stream>>>(p);
    phase_kernel<3><<<256, 512, LDS_BYTES, stream>>>(p);
    phase_kernel<4><<<256, 512, LDS_BYTES, stream>>>(p);
    phase_kernel<5><<<256, 512, LDS_BYTES, stream>>>(p);
    phase_kernel<6><<<256, 512, LDS_BYTES, stream>>>(p);
#endif
}
```

```cpp
#include <hip/hip_runtime.h>
#include <hip/hip_cooperative_groups.h>
#include <cstdio>
namespace cg = cooperative_groups;

#ifndef MK_SINGLE
#define MK_SINGLE 1
#endif

#define LAS __attribute__((address_space(3)))
typedef unsigned short bf16_t;
typedef short bf16x8 __attribute__((ext_vector_type(8)));
typedef float f32x4 __attribute__((ext_vector_type(4)));
typedef unsigned u32x4 __attribute__((ext_vector_type(4)));
typedef unsigned u32x2 __attribute__((ext_vector_type(2)));

constexpr int D_MODEL = 2048, MP = 8192, MS = 1024, MT = MP + MS, SEQ = 2048, NIN = 10240;
constexpr int DS = 1024, NG = 64;
constexpr float DN_ALPHA = 1.189207115002721f;
constexpr float LN_EPS = 1e-5f;
constexpr size_t O_Y = 0, O_SRP = (size_t)MT * D_MODEL, O_SIP = O_SRP + 16384, O_CVP = O_SIP + 16384, O_SRS = O_CVP + 8192, O_SIS = O_SRS + 524288, O_CVS = O_SIS + 524288;
constexpr size_t SZ_X = (size_t)MT * D_MODEL * 2;
constexpr size_t SZ_H = (size_t)MT * DS * 2;
constexpr size_t W_XB = 0;
constexpr size_t W_WINT = W_XB + SZ_X;
constexpr size_t W_WGLUT = W_WINT + (size_t)NIN * D_MODEL * 2;
constexpr size_t W_WOACT = W_WGLUT + (size_t)DS * DS * 2;
constexpr size_t W_WOT = W_WOACT + (size_t)2 * D_MODEL * DS * 2;
constexpr size_t W_PU = W_WOT + (size_t)D_MODEL * D_MODEL * 2;
constexpr size_t W_PZA = W_PU + SZ_H;
constexpr size_t W_PB = W_PZA + SZ_H;
constexpr size_t W_PC = W_PB + SZ_H;
constexpr size_t W_PH = W_PC + SZ_H;
constexpr size_t W_PZC = W_PH + SZ_H;
constexpr size_t W_PGA = W_PZC + SZ_H;
constexpr size_t W_PGC = W_PGA + SZ_X;
constexpr size_t W_BAR = W_PGC + SZ_X;
constexpr size_t W_CTL = W_BAR + 16384;
constexpr size_t W_G1 = W_CTL + 32768;
constexpr size_t W_END = W_G1 + SZ_H;
constexpr size_t W_YAC = W_WINT;
constexpr size_t W_MG = W_PB;

struct Params {
    const float *x_prompt, *x_sample, *st_re, *st_im, *st_conv, *w_in, *a_re, *a_im, *log_dt, *b_re, *b_im, *c_re, *c_im, *ssm_d, *w_glu, *w_out_a, *conv_w, *w_out_c, *w_o, *ln_g, *ln_b;
    float* out;
    unsigned char* ws;
};

typedef __bf16 bf16v2 __attribute__((ext_vector_type(2)));
typedef float f32v2 __attribute__((ext_vector_type(2)));
__device__ __forceinline__ unsigned cvt_pk_bf16(float lo, float hi) { const f32v2 v = {lo, hi}; const bf16v2 b = __builtin_convertvector(v, bf16v2); return __builtin_bit_cast(unsigned, b); }
__device__ __forceinline__ int tid_opaque() { int t = threadIdx.x; asm volatile("" : "+v"(t)); return t; }
__device__ __forceinline__ float bf_lo(unsigned w) { return __uint_as_float(w << 16); }
__device__ __forceinline__ float bf_hi(unsigned w) { return __uint_as_float(w & 0xffff0000u); }
__device__ __forceinline__ bf16_t f2bf(float f) { return (bf16_t)(cvt_pk_bf16(f, 0.f) & 0xffffu); }
__device__ __forceinline__ float sigmoidf_(float x) { return __builtin_amdgcn_rcpf(1.0f + __expf(-x)); }
__device__ __forceinline__ float siluf_(float x) { return x * sigmoidf_(x); }
__device__ __forceinline__ float gelu_tanh(float y) { const float z = 0.7978845608028654f * (y + 0.044715f * y * y * y); return y * sigmoidf_(2.0f * z); }

#define XB_TMO      128
#define XB_XCNT(j)  (256  + 64 * (j))
#define XB_XSUB(j)  (1280 + 64 * (j))
#define XB_XGEN(j)  (2304 + 64 * (j))
#define XB_TOP      3328
#define XB_TOPGEN   3392
#define XCD_BAR_WORDS 3456
#define XB_SPIN_CAP (1u << 18)
__device__ __forceinline__ unsigned xb_ld(unsigned* p)              { return __hip_atomic_load(p, __ATOMIC_RELAXED, __HIP_MEMORY_SCOPE_AGENT); }
__device__ __forceinline__ unsigned xb_add(unsigned* p, unsigned v) { return __hip_atomic_fetch_add(p, v, __ATOMIC_RELAXED, __HIP_MEMORY_SCOPE_AGENT); }
__device__ __forceinline__ unsigned xb_xcc_id() { return (unsigned)__builtin_amdgcn_s_getreg((3 << 11) | 20) & 0xFu; }
#define XB_SPIN(cond, bar) do { unsigned _sp = 0; while (cond) { __builtin_amdgcn_s_sleep(1); \
    if ((++_sp & 255u) == 0u) { if (xb_ld(&(bar)[XB_TMO])) break; if (_sp > XB_SPIN_CAP) { atomicAdd(&(bar)[XB_TMO], 1u); break; } } } } while (0)

struct XcdBarrier {
    unsigned* bar; unsigned x;
    volatile LAS unsigned* st;
};

__device__ __forceinline__ XcdBarrier xcd_barrier_post(unsigned* bar, volatile LAS unsigned* st) {
    XcdBarrier b; b.bar = bar; b.x = xb_xcc_id(); b.st = st;
    if (threadIdx.x == 0) (void)xb_add(&bar[XB_XCNT(b.x)], 1u);
    return b;
}
__device__ __forceinline__ void xcd_barrier_complete(unsigned* bar, unsigned x, unsigned& nloc, unsigned& nx) {
    const unsigned G = gridDim.x * gridDim.y * gridDim.z;
    unsigned sum, cnt, mine, sp = 0u;
    for (;;) {
        sum = 0u; cnt = 0u; mine = 0u;
#pragma unroll
        for (unsigned j = 0; j < 16; ++j) { const unsigned c = xb_ld(&bar[XB_XCNT(j)]); sum += c; cnt += (c > 0u) ? 1u : 0u; mine = (j == x) ? c : mine; }
        if (sum == G) break;
        __builtin_amdgcn_s_sleep(1);
        if ((++sp & 255u) == 0u) { if (xb_ld(&bar[XB_TMO])) break; if (sp > XB_SPIN_CAP) { atomicAdd(&bar[XB_TMO], 1u); break; } }
    }
    nloc = mine > 0u ? mine : 1u; nx = cnt > 0u ? cnt : 1u;
}

__device__ __forceinline__ void xcd_barrier(const XcdBarrier& b) {
    asm volatile("s_waitcnt vmcnt(0)" ::: "memory");
    __syncthreads();
    if (threadIdx.x == 0) {
        unsigned* bar = b.bar;
        __builtin_amdgcn_s_waitcnt(0);
        unsigned nloc = b.st[0], nx = b.st[1];
        if (nloc == 0u) { xcd_barrier_complete(bar, b.x, nloc, nx); b.st[0] = nloc; b.st[1] = nx; }
        const unsigned old = xb_add(&bar[XB_XSUB(b.x)], 1u);
        const unsigned gen = old / nloc;
        if (old + 1u == (gen + 1u) * nloc) {
            __builtin_amdgcn_fence(__ATOMIC_RELEASE, "agent");
            asm volatile("s_waitcnt vmcnt(0)" ::: "memory");
            const unsigned og = xb_add(&bar[XB_TOP], 1u);
            const unsigned tg = og / nx;
            if (og + 1u == (tg + 1u) * nx) xb_add(&bar[XB_TOPGEN], 1u);
            else XB_SPIN(xb_ld(&bar[XB_TOPGEN]) == tg, bar);
            __builtin_amdgcn_fence(__ATOMIC_ACQUIRE, "agent");
            xb_add(&bar[XB_XGEN(b.x)], 1u);
            asm volatile("s_waitcnt vmcnt(0)" ::: "memory");
        } else {
            XB_SPIN(xb_ld(&bar[XB_XGEN(b.x)]) == gen, bar);
            __builtin_amdgcn_fence(__ATOMIC_ACQUIRE, "agent");
            asm volatile("s_waitcnt vmcnt(0)" ::: "memory");
        }
    }
    __syncthreads();
}

namespace pg8 {
constexpr int BM = 256, BK = 64, HALF = 128, HTB = HALF * BK * 2, STAGE_BYTES = 8 * HTB, NXCD = 8, WGM = 8;
__host__ __device__ __forceinline__ int lds_byte(int r, int c) { const int st = (r >> 4) * 2 + (c >> 5), rr = r & 15, cc = c & 31, ob = rr * 64 + cc * 2; return st * 1024 + (ob ^ (((ob >> 9) & 1) << 5)); }
__host__ __device__ __forceinline__ void stage_rc(int b, int& R, int& C) { const int st = b / 1024, sb = b % 1024, swz = sb ^ (((sb >> 9) & 1) << 5); R = (st >> 1) * 16 + swz / 64; C = (st & 1) * 32 + (swz % 64) / 2; }
__host__ __device__ __forceinline__ int perm32(int rho) { const int n = rho >> 4, i = rho & 15; return 8 * (i >> 2) + 4 * n + (i & 3); }
struct Unit { int pm, pn; };
struct Gemm { const bf16_t* A; const bf16_t* Bt; int K; };

__device__ __forceinline__ void tile_of(int L, int nM, int nN, Unit& u) {
    const int nwg = nM * nN; int wgid = L;
    { const int q = nwg / NXCD, r = nwg % NXCD, xcd = wgid % NXCD, off = wgid / NXCD; wgid = (xcd < r ? xcd * (q + 1) : r * (q + 1) + (xcd - r) * q) + off; }
    const int nig = WGM * nN, gid = wgid / nig, fm = gid * WGM, gsz = (nM - fm) < WGM ? (nM - fm) : WGM;
    u.pm = fm + ((wgid % nig) % gsz); u.pn = (wgid % nig) / gsz;
}
struct StaticOrder {
    int nM, nN, nwg, G, c;
    __device__ void init(int nM_, int nN_, int G_, int c_) { nM = nM_; nN = nN_; nwg = nM * nN; G = G_; c = c_; }
    __device__ __forceinline__ bool next(int i, Unit& u) const { const int L = i * G + c; if (L >= nwg) return false; tile_of(L, nM, nN, u); return true; }
};
struct PairOrder {
    int nM, nN, nwg, G, c;
    __device__ void init(int nM_, int nN_, int G_, int c_) { nM = nM_; nN = nN_; nwg = nM * nN; G = G_; c = c_; }
    __device__ __forceinline__ bool next(int i, Unit& u) const { const int L = (i >> 1) * G + c; if (L >= nwg) return false; tile_of(L, nM, nN, u); if (i & 1) { u.pm += nM; u.pn += nN; } return true; }
};

template <class Epi, class Sched>
__device__ __forceinline__ void gemm_phase(LAS unsigned char* lds, const Gemm g, const Sched& S, const Epi& E) {
    const int tid = tid_opaque(), wid = __builtin_amdgcn_readfirstlane(tid >> 6), lane = tid & 63, wr = wid >> 2, wc = wid & 3, fr = lane & 15, fq = lane >> 4;
    const int K = g.K, nt = K / BK;
    unsigned voffA[2], voffB[2];
#pragma unroll
    for (int i = 0; i < 2; ++i) { int R, C; stage_rc(tid * 16 + i * 8192, R, C); const int Rb = (R & ~31) + perm32(R & 31);
        voffA[i] = (unsigned)(R * K + C) * 2u; voffB[i] = (unsigned)(Rb * K + C) * 2u; }
    const size_t kstep = (size_t)(BK * 2);
    const size_t hstep = (size_t)HALF * K * 2;
    const size_t tstep = 2 * hstep;
    const unsigned ldsw = (unsigned)wid * 1024u;
    const int aoff = lds_byte(wr * 64 + fr, fq * 8), boff = lds_byte(wc * 32 + fr, fq * 8);
#define PG8_SA(b, h) (((b) * 2 + (h)) * HTB)
#define PG8_SB(b, h) ((4 + (b) * 2 + (h)) * HTB)
#define PG8_STAGE(bufoff, gbase, voff) do { _Pragma("unroll") for (int _i = 0; _i < 2; ++_i) \
        __builtin_amdgcn_global_load_lds((const unsigned*)((const char*)(gbase) + (voff)[_i]), (LAS unsigned*)(lds + (bufoff) + ldsw + _i * 8192), 16, 0, 0); } while (0)
#define PG8_LDA(dst, b, h) do { _Pragma("unroll") for (int m = 0; m < 4; ++m) _Pragma("unroll") for (int k = 0; k < 2; ++k) dst[m][k] = *(const LAS bf16x8*)(lds + PG8_SA(b, h) + aoff + m * 2048 + k * 1024); } while (0)
#define PG8_LDB(dst, b, h) do { _Pragma("unroll") for (int n = 0; n < 2; ++n) _Pragma("unroll") for (int k = 0; k < 2; ++k) dst[n][k] = *(const LAS bf16x8*)(lds + PG8_SB(b, h) + boff + n * 2048 + k * 1024); } while (0)
#define PG8_MMA(ai, bj, At, Bt) do { __builtin_amdgcn_s_setprio(1); _Pragma("unroll") for (int m = 0; m < 4; ++m) _Pragma("unroll") for (int n = 0; n < 2; ++n) _Pragma("unroll") for (int k = 0; k < 2; ++k) \
        acc[ai][bj][m][n] = __builtin_amdgcn_mfma_f32_16x16x32_bf16(Bt[n][k], At[m][k], acc[ai][bj][m][n], 0, 0, 0); __builtin_amdgcn_s_setprio(0); } while (0)
#define PG8_WAIT_V(n) asm volatile("s_waitcnt vmcnt(" #n ")" ::: "memory")
#define PG8_WAIT_L(n) asm volatile("s_waitcnt lgkmcnt(" #n ")" ::: "memory")
#define PG8_BAR __builtin_amdgcn_s_barrier()
#define PG8_SCHED __builtin_amdgcn_sched_barrier(0)
    Unit cur, nxt; int ui = 0;
    if (!S.next(0, cur)) return;
    f32x4 acc[2][2][4][2];
#pragma unroll
    for (int a = 0; a < 2; ++a)
#pragma unroll
        for (int b = 0; b < 2; ++b)
#pragma unroll
            for (int m = 0; m < 4; ++m)
#pragma unroll
                for (int n = 0; n < 2; ++n) acc[a][b][m][n] = (f32x4){0.f, 0.f, 0.f, 0.f};
    bf16x8 At[4][2], B0[2][2], B1[2][2];
    const char* cA = (const char*)g.A + (size_t)cur.pm * tstep; const char* cB = (const char*)g.Bt + (size_t)cur.pn * tstep;
    PG8_STAGE(PG8_SB(0, 0), cB, voffB); PG8_STAGE(PG8_SA(0, 0), cA, voffA); PG8_STAGE(PG8_SB(0, 1), cB + hstep, voffB); PG8_STAGE(PG8_SA(0, 1), cA + hstep, voffA);
    if (wr == 1) PG8_BAR;
    PG8_WAIT_V(4); PG8_BAR;
    PG8_STAGE(PG8_SB(1, 0), cB + kstep, voffB); PG8_STAGE(PG8_SA(1, 0), cA + kstep, voffA); PG8_STAGE(PG8_SB(1, 1), cB + hstep + kstep, voffB);
    PG8_WAIT_V(6); PG8_BAR;
    for (;;) {
        const bool has_next = S.next(ui + 1, nxt);
        const char* nA = has_next ? (const char*)g.A + (size_t)nxt.pm * tstep : cA; const char* nB = has_next ? (const char*)g.Bt + (size_t)nxt.pn * tstep : cB;
        for (int t = 0; t < nt; t += 2) {
            const bool last = (t == nt - 2);
            const char* a1 = cA + (size_t)(t + 1) * kstep;
            const char* a2 = last ? nA : cA + (size_t)(t + 2) * kstep; const char* b2 = last ? nB : cB + (size_t)(t + 2) * kstep;
            const char* a3 = a2 + kstep; const char* b3 = b2 + kstep;
            PG8_LDB(B0, 0, 0); PG8_SCHED; PG8_LDA(At, 0, 0); PG8_STAGE(PG8_SA(1, 1), a1 + hstep, voffA);
            PG8_WAIT_L(8); PG8_BAR; PG8_WAIT_L(0); PG8_MMA(0, 0, At, B0); PG8_BAR; PG8_SCHED;
            PG8_LDB(B1, 0, 1); PG8_STAGE(PG8_SB(0, 0), b2, voffB);
            PG8_BAR; PG8_WAIT_L(0); PG8_MMA(0, 1, At, B1); PG8_BAR;
            PG8_LDA(At, 0, 1); PG8_STAGE(PG8_SA(0, 0), a2, voffA);
            PG8_BAR; PG8_WAIT_L(0); PG8_MMA(1, 0, At, B0); PG8_BAR; PG8_SCHED;
            PG8_STAGE(PG8_SB(0, 1), b2 + hstep, voffB);
            PG8_WAIT_V(6); PG8_BAR; PG8_MMA(1, 1, At, B1); PG8_BAR;
            PG8_LDB(B0, 1, 0); PG8_SCHED; PG8_LDA(At, 1, 0); PG8_STAGE(PG8_SA(0, 1), a2 + hstep, voffA);
            PG8_WAIT_L(8); PG8_BAR; PG8_WAIT_L(0); PG8_MMA(0, 0, At, B0); PG8_BAR; PG8_SCHED;
            PG8_LDB(B1, 1, 1); PG8_STAGE(PG8_SB(1, 0), b3, voffB);
            PG8_BAR; PG8_WAIT_L(0); PG8_MMA(0, 1, At, B1); PG8_BAR;
            PG8_LDA(At, 1, 1); PG8_STAGE(PG8_SA(1, 0), a3, voffA);
            PG8_BAR; PG8_WAIT_L(0); PG8_MMA(1, 0, At, B0); PG8_BAR; PG8_SCHED;
            PG8_STAGE(PG8_SB(1, 1), b3 + hstep, voffB);
            PG8_WAIT_V(6); PG8_BAR; PG8_MMA(1, 1, At, B1); PG8_BAR;
        }
        E(acc, cur, wr, wc, fr, fq);
        if (!has_next) break;
#pragma unroll
        for (int a = 0; a < 2; ++a)
#pragma unroll
            for (int b = 0; b < 2; ++b)
#pragma unroll
                for (int m = 0; m < 4; ++m)
#pragma unroll
                    for (int n = 0; n < 2; ++n) acc[a][b][m][n] = (f32x4){0.f, 0.f, 0.f, 0.f};
        cur = nxt; cA = nA; cB = nB; ++ui;
    }
    PG8_WAIT_V(0);
    if (wr == 0) PG8_BAR;
    PG8_BAR;
#undef PG8_SA
#undef PG8_SB
#undef PG8_STAGE
#undef PG8_LDA
#undef PG8_LDB
#undef PG8_MMA
#undef PG8_WAIT_V
#undef PG8_WAIT_L
#undef PG8_BAR
#undef PG8_SCHED
}
}

#define EPI_LOOP_BEGIN \
    _Pragma("unroll") for (int ai = 0; ai < 2; ++ai) _Pragma("unroll") for (int m = 0; m < 4; ++m) _Pragma("unroll") for (int bj = 0; bj < 2; ++bj) { \
        const int rl = ai * 128 + wr * 64 + m * 16 + fr, cl = bj * 128 + wc * 32 + 8 * fq; const f32x4 v0 = acc[ai][bj][m][0], v1 = acc[ai][bj][m][1];
#define EPI_LOOP_END }

__device__ __forceinline__ u32x4 pack8(const f32x4 a, const f32x4 b) { u32x4 o; o[0] = cvt_pk_bf16(a[0], a[1]); o[1] = cvt_pk_bf16(a[2], a[3]); o[2] = cvt_pk_bf16(b[0], b[1]); o[3] = cvt_pk_bf16(b[2], b[3]); return o; }

struct EpiProj {
    unsigned char* ws;
    __device__ __forceinline__ void operator()(const f32x4 (&acc)[2][2][4][2], const pg8::Unit& u, int wr, int wc, int fr, int fq) const {
        const int pn = u.pn, row0 = u.pm * 256;
        if (pn < 4) {
            bf16_t* PU = (bf16_t*)(ws + W_PU);
            EPI_LOOP_BEGIN
                const int ch = pn * 256 + cl, g = ch >> 4, half = (ch >> 3) & 1;
                *(u32x4*)(PU + ((size_t)g * MT + row0 + rl) * 16 + half * 8) = pack8(v0, v1);
            EPI_LOOP_END
            return;
        }
        if (pn >= 8 && pn < 24) {
            bf16_t* dst = (bf16_t*)(ws + (wc < 2 ? W_PC : W_PB)) + (pn - 8) * 64 + (wc & 1) * 32 + 8 * fq;
#pragma unroll
            for (int ai = 0; ai < 2; ++ai)
#pragma unroll
                for (int m = 0; m < 4; ++m) {
                    const int rl = ai * 128 + wr * 64 + m * 16 + fr;
                    f32x4 a = acc[ai][0][m][0], b = acc[ai][0][m][1]; const f32x4 a2 = acc[ai][1][m][0], b2 = acc[ai][1][m][1];
                    if (wc < 2) { a = a * a2; b = b * b2; }
                    else { _Pragma("unroll") for (int j = 0; j < 4; ++j) { a[j] *= siluf_(a2[j]); b[j] *= siluf_(b2[j]); } }
                    *(u32x4*)(dst + (size_t)(row0 + rl) * 1024) = pack8(a, b);
                }
            return;
        }
        bf16_t* base; int ld, colt, act;
        if (pn < 8) { colt = (pn & 3) * 256; ld = 1024; act = 1; base = (bf16_t*)(ws + W_PZA); }
        else {
            bf16_t* SA = (bf16_t*)(ws + W_PGA) + (pn - 24) * 128 + wc * 32 + 8 * fq; bf16_t* RT = (bf16_t*)(ws + W_PGC) + (pn - 24) * 128 + wc * 32 + 8 * fq;
#pragma unroll
            for (int ai = 0; ai < 2; ++ai)
#pragma unroll
                for (int m = 0; m < 4; ++m) {
                    const int rl = ai * 128 + wr * 64 + m * 16 + fr;
                    f32x4 s0, s1, r0, r1;
#pragma unroll
                    for (int j = 0; j < 4; ++j) {
                        const float ea0 = fminf(__expf(-acc[ai][0][m][0][j]), 1e30f), ec0 = __expf(-acc[ai][1][m][0][j]), ea1 = fminf(__expf(-acc[ai][0][m][1][j]), 1e30f), ec1 = __expf(-acc[ai][1][m][1][j]);
                        s0[j] = __builtin_amdgcn_rcpf(1.0f + ea0); r0[j] = (1.0f + ea0) * __builtin_amdgcn_rcpf(1.0f + ec0);
                        s1[j] = __builtin_amdgcn_rcpf(1.0f + ea1); r1[j] = (1.0f + ea1) * __builtin_amdgcn_rcpf(1.0f + ec1); }
                    *(u32x4*)(SA + (size_t)(row0 + rl) * 2048) = pack8(s0, s1); *(u32x4*)(RT + (size_t)(row0 + rl) * 2048) = pack8(r0, r1);
                }
            return;
        }
        EPI_LOOP_BEGIN
            f32x4 a = v0, b = v1;
            if (act == 1) { _Pragma("unroll") for (int j = 0; j < 4; ++j) { a[j] = siluf_(a[j]); b[j] = siluf_(b[j]); } }
            else if (act == 2) { _Pragma("unroll") for (int j = 0; j < 4; ++j) { a[j] = sigmoidf_(a[j]); b[j] = sigmoidf_(b[j]); } }
            *(u32x4*)(base + (size_t)(row0 + rl) * ld + colt + cl) = pack8(a, b);
        EPI_LOOP_END
    }
};
#define EPI_HALF_BEGIN _Pragma("unroll") for (int ai = 0; ai < 2; ++ai) {
#define EPI_HALF_END }
#define EPI_MB_LOOP _Pragma("unroll") for (int m = 0; m < 4; ++m) _Pragma("unroll") for (int bj = 0; bj < 2; ++bj)
#define EPI_RL (ai * 128 + wr * 64 + m * 16 + fr)
#define EPI_CL (bj * 128 + wc * 32 + 8 * fq)
struct EpiGlu {
    unsigned char* ws;
    __device__ __forceinline__ void operator()(const f32x4 (&acc)[2][2][4][2], const pg8::Unit& u, int wr, int wc, int fr, int fq) const {
        const bf16_t* G1 = (const bf16_t*)(ws + W_G1); const bf16_t* ZA = (const bf16_t*)(ws + W_PZA); bf16_t* YA = (bf16_t*)(ws + W_YAC);
        EPI_HALF_BEGIN
            u32x4 gv[4][2], zv[4][2];
            EPI_MB_LOOP { const size_t o = (size_t)(u.pm * 256 + EPI_RL) * 1024 + u.pn * 256 + EPI_CL; gv[m][bj] = *(const u32x4*)(G1 + o); zv[m][bj] = *(const u32x4*)(ZA + o); }
            EPI_MB_LOOP { const size_t o = (size_t)(u.pm * 256 + EPI_RL) * 1024 + u.pn * 256 + EPI_CL;
                const f32x4 v0 = acc[ai][bj][m][0], v1 = acc[ai][bj][m][1]; const u32x4 g = gv[m][bj], z = zv[m][bj];
                f32x4 a, b;
                a[0] = bf_lo(g[0]) * sigmoidf_(v0[0]) * bf_lo(z[0]); a[1] = bf_hi(g[0]) * sigmoidf_(v0[1]) * bf_hi(z[0]);
                a[2] = bf_lo(g[1]) * sigmoidf_(v0[2]) * bf_lo(z[1]); a[3] = bf_hi(g[1]) * sigmoidf_(v0[3]) * bf_hi(z[1]);
                b[0] = bf_lo(g[2]) * sigmoidf_(v1[0]) * bf_lo(z[2]); b[1] = bf_hi(g[2]) * sigmoidf_(v1[1]) * bf_hi(z[2]);
                b[2] = bf_lo(g[3]) * sigmoidf_(v1[2]) * bf_lo(z[3]); b[3] = bf_hi(g[3]) * sigmoidf_(v1[3]) * bf_hi(z[3]);
                *(u32x4*)(YA + o) = pack8(a, b); }
        EPI_HALF_END
    }
};
struct EpiMerge {
    unsigned char* ws;
    __device__ __forceinline__ void operator()(const f32x4 (&acc)[2][2][4][2], const pg8::Unit& u, int wr, int wc, int fr, int fq) const {
        const bool second = u.pm >= 36; const int pm = second ? u.pm - 36 : u.pm, pn = second ? u.pn - 8 : u.pn;
        const bf16_t* GT = (const bf16_t*)(ws + (second ? W_PGC : W_PGA)); bf16_t* MG = (bf16_t*)(ws + W_MG);
        EPI_HALF_BEGIN
            u32x4 gv[4][2], pv[4][2];
            EPI_MB_LOOP { const size_t o = (size_t)(pm * 256 + EPI_RL) * 2048 + pn * 256 + EPI_CL; gv[m][bj] = *(const u32x4*)(GT + o); }
            if (second) { EPI_MB_LOOP { const size_t o = (size_t)(pm * 256 + EPI_RL) * 2048 + pn * 256 + EPI_CL; pv[m][bj] = *(const u32x4*)(MG + o); } }
            else { EPI_MB_LOOP pv[m][bj] = (u32x4){0u, 0u, 0u, 0u}; }
            EPI_MB_LOOP { const size_t o = (size_t)(pm * 256 + EPI_RL) * 2048 + pn * 256 + EPI_CL;
                const f32x4 v0 = acc[ai][bj][m][0], v1 = acc[ai][bj][m][1]; const u32x4 g = gv[m][bj], q = pv[m][bj];
                f32x4 a, b;
                a[0] = bf_lo(g[0]) * v0[0] + bf_lo(q[0]); a[1] = bf_hi(g[0]) * v0[1] + bf_hi(q[0]); a[2] = bf_lo(g[1]) * v0[2] + bf_lo(q[1]); a[3] = bf_hi(g[1]) * v0[3] + bf_hi(q[1]);
                b[0] = bf_lo(g[2]) * v1[0] + bf_lo(q[2]); b[1] = bf_hi(g[2]) * v1[1] + bf_hi(q[2]); b[2] = bf_lo(g[3]) * v1[2] + bf_lo(q[3]); b[3] = bf_hi(g[3]) * v1[3] + bf_hi(q[3]);
                *(u32x4*)(MG + o) = pack8(a, b); }
        EPI_HALF_END
    }
};
struct EpiResid {
    const float* xp; const float* xs; float* out;
    __device__ __forceinline__ void operator()(const f32x4 (&acc)[2][2][4][2], const pg8::Unit& u, int wr, int wc, int fr, int fq) const {
        EPI_HALF_BEGIN
            f32x4 x0[4][2], x1[4][2];
            EPI_MB_LOOP { const int row = u.pm * 256 + EPI_RL, col = u.pn * 256 + EPI_CL;
                const float* xr = row < MP ? xp + (size_t)row * D_MODEL : xs + (size_t)(row - MP) * D_MODEL;
                x0[m][bj] = *(const f32x4*)(xr + col); x1[m][bj] = *(const f32x4*)(xr + col + 4); }
            EPI_MB_LOOP { const int row = u.pm * 256 + EPI_RL, col = u.pn * 256 + EPI_CL;
                float* o = out + (size_t)row * D_MODEL + col;
                *(f32x4*)o = x0[m][bj] * DN_ALPHA + acc[ai][bj][m][0]; *(f32x4*)(o + 4) = x1[m][bj] * DN_ALPHA + acc[ai][bj][m][1]; }
        EPI_HALF_END
    }
};

__device__ __forceinline__ void transpose_tile(const float* __restrict__ W, int K, int N, bf16_t* __restrict__ Wt, int kt, int ntile, LAS float* tile, int ldt, int kd0, int nd0) {
    const int t = tid_opaque(), k0 = kt * 64, n0 = ntile * 64;
    const int r = t >> 4, c4 = (t & 15) * 4;
#pragma unroll
    for (int h = 0; h < 2; ++h) { const f32x4 v = __builtin_nontemporal_load((const f32x4*)(W + (size_t)(k0 + r + 32 * h) * N + n0 + c4));
#pragma unroll
        for (int j = 0; j < 4; ++j) tile[(r + 32 * h) * 65 + c4 + j] = v[j]; }
    __syncthreads();
    const int n = t >> 3, k8 = (t & 7) * 8;
    float v[8];
#pragma unroll
    for (int j = 0; j < 8; ++j) v[j] = tile[(k8 + j) * 65 + n];
    u32x4 o; o[0] = cvt_pk_bf16(v[0], v[1]); o[1] = cvt_pk_bf16(v[2], v[3]); o[2] = cvt_pk_bf16(v[4], v[5]); o[3] = cvt_pk_bf16(v[6], v[7]);
    *(u32x4*)(Wt + (size_t)(nd0 + n) * ldt + kd0 + k8) = o;
    __syncthreads();
}
__device__ __forceinline__ void phase_convert(const Params& p, LAS unsigned char* lds) {
    const int G = gridDim.x, bid = blockIdx.x, tid = tid_opaque();
    {
        bf16_t* XB = (bf16_t*)(p.ws + W_XB);
        const size_t nitems = (size_t)MT * D_MODEL / 8, np = (size_t)MP * D_MODEL / 8;
        for (size_t i = (size_t)bid * 512 + tid; i < nitems; i += (size_t)G * 512) {
            const float* src = i < np ? p.x_prompt + i * 8 : p.x_sample + (i - np) * 8;
            const f32x4 a = __builtin_nontemporal_load((const f32x4*)src), b = __builtin_nontemporal_load((const f32x4*)(src + 4));
            *(u32x4*)(XB + i * 8) = pack8(a, b);
        }
    }
    LAS float* tile = (LAS float*)lds;
    for (int j = bid; j < 5120; j += G) { const int nt64 = j % 160, n0 = nt64 * 64; int nd0 = n0;
        if (n0 >= 6144) { const int kind = (n0 - 6144) >> 11, c0 = (n0 - 6144) & 2047; nd0 = 6144 + (c0 >> 7) * 256 + kind * 128 + ((c0 >> 6) & 1) * 64; }
        else if (n0 >= 2048 && n0 < 6144) { const int kind = (n0 - 2048) >> 10, t64 = ((n0 - 2048) & 1023) >> 6, slot = kind == 0 ? 1 : kind == 1 ? 0 : kind; nd0 = 2048 + t64 * 256 + slot * 64; }
        transpose_tile(p.w_in, 2048, NIN, (bf16_t*)(p.ws + W_WINT), j / 160, nt64, tile, 2048, (j / 160) * 64, nd0); }
}
__device__ __forceinline__ void phase_convert_late(const Params& p, LAS unsigned char* lds, int bidx, int nblk) {
    LAS float* tile = (LAS float*)lds;
    for (int j = bidx; j < 2304; j += nblk) {
        const float* W; bf16_t* Wt; int K, N, jj;
        if (j < 512) { W = p.w_out_a; Wt = (bf16_t*)(p.ws + W_WOACT); K = 1024; N = 2048; jj = j; }
        else if (j < 1024) { W = p.w_out_c; Wt = (bf16_t*)(p.ws + W_WOACT) + (size_t)2048 * 1024; K = 1024; N = 2048; jj = j - 512; }
        else if (j < 2048) { W = p.w_o; Wt = (bf16_t*)(p.ws + W_WOT); K = 2048; N = 2048; jj = j - 1024; }
        else { W = p.w_glu; Wt = (bf16_t*)(p.ws + W_WGLUT); K = 1024; N = 1024; jj = j - 2048; }
        const int nn = N / 64, kt = jj / nn; int kd0 = kt * 64;
        if (K == 2048 && kd0 >= 1024) { kd0 -= 1024; Wt += (size_t)2048 * 1024; }
        transpose_tile(W, K, N, Wt, kt, jj % nn, tile, 1024, kd0, (jj % nn) * 64);
    }
}

constexpr int L_LAM = 0, L_E = 4608, L_WT = L_E + 4096, L_VT = L_WT + 128 * 272, L_KM = L_VT + 144 * 272, L_U = L_KM + 4096, L_HIN = L_U + 64 * 272, L_S = L_HIN + 64 * 272, L_SSM_END = L_S + 32768;
constexpr int L_BBT = L_U;
constexpr int LDS_BYTES = 155648;
static_assert(L_SSM_END <= LDS_BYTES - 32, "lds");
static_assert(pg8::STAGE_BYTES <= LDS_BYTES - 32, "lds");

__device__ __forceinline__ void ssm_setup(const Params& p, int g, LAS unsigned char* lds, int w, int fr, int fq) {
    const int tid = tid_opaque();
    LAS float* lam = (LAS float*)(lds + L_LAM);
    LAS float* bbar = (LAS float*)(lds + L_S);
    LAS float* ct = (LAS float*)(lds + L_S + 8192);
    LAS float* qv = (LAS float*)(lds + L_S + 16384);
    __syncthreads();
    {
        const float dt = expf(p.log_dt[g]);
        for (int e = tid; e < 576; e += 512) { const int k = e >> 6, pp = e & 63; const float ar = p.a_re[g * 64 + pp], ai = p.a_im[g * 64 + pp];
            const float mg = expf((float)k * (ar * dt)), a = (float)k * (ai * dt); lam[e * 2] = mg * cosf(a); lam[e * 2 + 1] = mg * sinf(a); }
        if (tid < 64) { const float ar = p.a_re[g * 64 + tid], ai = p.a_im[g * 64 + tid], ang = ai * dt, x = ar * dt;
            const float em1 = expm1f(x), mg = em1 + 1.0f, sh = sinf(0.5f * ang);
            const float lrm1 = em1 - 2.0f * mg * sh * sh, li = mg * sinf(ang), den = ar * ar + ai * ai;
            qv[tid * 2] = (lrm1 * ar + li * ai) / den; qv[tid * 2 + 1] = (li * ar - lrm1 * ai) / den; }
#pragma unroll
        for (int j = 0; j < 2; ++j) { const int e = tid + 512 * j; ct[e * 2] = p.c_re[(size_t)g * 1024 + e]; ct[e * 2 + 1] = p.c_im[(size_t)g * 1024 + e]; }
    }
    __syncthreads();
#pragma unroll
    for (int j = 0; j < 2; ++j) {
        const int e = tid + 512 * j, pp = e >> 4;
        const float br = p.b_re[(size_t)g * 1024 + e], bi = p.b_im[(size_t)g * 1024 + e], qr = qv[pp * 2], qi = qv[pp * 2 + 1];
        bbar[e * 2] = qr * br - qi * bi; bbar[e * 2 + 1] = qr * bi + qi * br;
    }
    __syncthreads();
#pragma unroll
    for (int j = 0; j < 4; ++j) {
        const int it = tid + 512 * j, n = it >> 4, oct = it & 15, ri = n >> 6, pp = n & 63, s = oct >> 1, c0 = (oct & 1) * 8;
        const float lr = lam[((7 - s) * 64 + pp) * 2], li = lam[((7 - s) * 64 + pp) * 2 + 1];
        float v[8];
#pragma unroll
        for (int q = 0; q < 4; ++q) { const f32x4 bb = *(const LAS f32x4*)(bbar + (pp * 16 + c0 + 2 * q) * 2);
            v[2 * q] = ri == 0 ? lr * bb[0] - li * bb[1] : lr * bb[1] + li * bb[0]; v[2 * q + 1] = ri == 0 ? lr * bb[2] - li * bb[3] : lr * bb[3] + li * bb[2]; }
        u32x4 o; o[0] = cvt_pk_bf16(v[0], v[1]); o[1] = cvt_pk_bf16(v[2], v[3]); o[2] = cvt_pk_bf16(v[4], v[5]); o[3] = cvt_pk_bf16(v[6], v[7]);
        *(LAS u32x4*)(lds + L_WT + n * 272 + oct * 16) = o;
    }
    if (tid < 256) {
        const int c = tid >> 4, oct = tid & 15, ri = oct >> 3, p0 = (oct & 7) * 8;
        float v[8];
#pragma unroll
        for (int q = 0; q < 8; ++q) v[q] = bbar[((p0 + q) * 16 + c) * 2 + ri];
        u32x4 o; o[0] = cvt_pk_bf16(v[0], v[1]); o[1] = cvt_pk_bf16(v[2], v[3]); o[2] = cvt_pk_bf16(v[4], v[5]); o[3] = cvt_pk_bf16(v[6], v[7]);
        *(LAS u32x4*)(lds + L_BBT + c * 272 + oct * 16) = o;
    }
    for (int it = tid; it < 2304; it += 512) {
        const int n = it >> 4, oct = it & 15, k = n >> 4, c = n & 15, ri = oct >> 3, p0 = (oct & 7) * 8;
        float v[8];
#pragma unroll
        for (int q = 0; q < 4; ++q) { const f32x4 ll = *(const LAS f32x4*)(lam + (k * 64 + p0 + 2 * q) * 2), cc = *(const LAS f32x4*)(ct + (c * 64 + p0 + 2 * q) * 2);
            v[2 * q] = ri == 0 ? cc[0] * ll[0] - cc[1] * ll[1] : -(cc[0] * ll[1] + cc[1] * ll[0]); v[2 * q + 1] = ri == 0 ? cc[2] * ll[2] - cc[3] * ll[3] : -(cc[2] * ll[3] + cc[3] * ll[2]); }
        u32x4 o; o[0] = cvt_pk_bf16(v[0], v[1]); o[1] = cvt_pk_bf16(v[2], v[3]); o[2] = cvt_pk_bf16(v[4], v[5]); o[3] = cvt_pk_bf16(v[6], v[7]);
        *(LAS u32x4*)(lds + L_VT + n * 272 + oct * 16) = o;
    }
    __syncthreads();
    {
        f32x4 acc = {0.f, 0.f, 0.f, 0.f};
#pragma unroll
        for (int kk = 0; kk < 4; ++kk) {
            const bf16x8 bq = *(const LAS bf16x8*)(lds + L_BBT + fr * 272 + kk * 64 + fq * 16);
            const bf16x8 av = *(const LAS bf16x8*)(lds + L_VT + (w * 16 + fr) * 272 + kk * 64 + fq * 16);
            acc = __builtin_amdgcn_mfma_f32_16x16x32_bf16(bq, av, acc, 0, 0, 0);
        }
        u32x2 o; o[0] = cvt_pk_bf16(acc[0], acc[1]); o[1] = cvt_pk_bf16(acc[2], acc[3]);
        *(LAS u32x2*)(lds + L_KM + ((w * 16 + fr) * 16 + fq * 4) * 2) = o;
    }
    __syncthreads();
}

__device__ __forceinline__ void ssm_pass_a(LAS unsigned char* lds, int nrb, int w, int fr, int fq) {
    bf16x8 bw[4];
#pragma unroll
    for (int kk = 0; kk < 4; ++kk) bw[kk] = *(const LAS bf16x8*)(lds + L_WT + (w * 16 + fr) * 272 + kk * 64 + fq * 16);
    LAS float* S = (LAS float*)(lds + L_S);
    for (int rb = 0; rb < nrb; ++rb) {
        f32x4 acc = {0.f, 0.f, 0.f, 0.f};
#pragma unroll
        for (int kk = 0; kk < 4; ++kk) { const bf16x8 a = *(const LAS bf16x8*)(lds + L_U + (rb * 16 + fr) * 272 + kk * 64 + fq * 16); acc = __builtin_amdgcn_mfma_f32_16x16x32_bf16(a, bw[kk], acc, 0, 0, 0); }
#pragma unroll
        for (int j = 0; j < 4; ++j) S[(rb * 16 + fq * 4 + j) * 128 + w * 16 + fr] = acc[j];
    }
}
__device__ __forceinline__ void ssm_pass_c(const Params& p, LAS unsigned char* lds, int nrb, int t, int fr, int fq, int g, int tok_base) {
    bf16_t* G1 = (bf16_t*)(p.ws + W_G1);
    const f32x4 dv = *(const f32x4*)(p.ssm_d + g * 16 + fq * 4);
    for (int rb = 0; rb < nrb; ++rb) {
        f32x4 acc = {0.f, 0.f, 0.f, 0.f};
#pragma unroll
        for (int kk = 0; kk < 4; ++kk) {
            const bf16x8 bv = *(const LAS bf16x8*)(lds + L_VT + ((t + 1) * 16 + fr) * 272 + kk * 64 + fq * 16);
            const bf16x8 ah = *(const LAS bf16x8*)(lds + L_HIN + (rb * 16 + fr) * 272 + kk * 64 + fq * 16);
            acc = __builtin_amdgcn_mfma_f32_16x16x32_bf16(bv, ah, acc, 0, 0, 0);
        }
#pragma unroll
        for (int kk = 0; kk < 4; ++kk) {
            if (2 * kk <= t) {
                const int lag = t - 2 * kk - (fq >> 1);
                bf16x8 bk = *(const LAS bf16x8*)(lds + L_KM + (((lag < 0 ? 0 : lag) * 16 + fr) * 16 + (fq & 1) * 8) * 2);
                if (lag < 0) bk = (bf16x8){0, 0, 0, 0, 0, 0, 0, 0};
                const bf16x8 au = *(const LAS bf16x8*)(lds + L_U + (rb * 16 + fr) * 272 + kk * 64 + fq * 16);
                acc = __builtin_amdgcn_mfma_f32_16x16x32_bf16(bk, au, acc, 0, 0, 0);
            }
        }
        const int rr = rb * 16 + fr;
        const u32x2 uv = *(const LAS u32x2*)(lds + L_U + rr * 272 + (t * 16 + fq * 4) * 2);
        f32x4 y;
        y[0] = gelu_tanh(acc[0] + dv[0] * bf_lo(uv[0])); y[1] = gelu_tanh(acc[1] + dv[1] * bf_hi(uv[0]));
        y[2] = gelu_tanh(acc[2] + dv[2] * bf_lo(uv[1])); y[3] = gelu_tanh(acc[3] + dv[3] * bf_hi(uv[1]));
        u32x2 o; o[0] = cvt_pk_bf16(y[0], y[1]); o[1] = cvt_pk_bf16(y[2], y[3]);
        *(u32x2*)(G1 + (size_t)(tok_base + rr * 8 + t) * 1024 + g * 16 + fq * 4) = o;
    }
}

__device__ __forceinline__ void unpack8(const u32x4 v, float (&f)[8]) { f[0] = bf_lo(v[0]); f[1] = bf_hi(v[0]); f[2] = bf_lo(v[1]); f[3] = bf_hi(v[1]); f[4] = bf_lo(v[2]); f[5] = bf_hi(v[2]); f[6] = bf_lo(v[3]); f[7] = bf_hi(v[3]); }
constexpr int CONV_ITEMS = (MT / 8) * 128;
template <int T0, int T1> __device__ __forceinline__ void conv_issue(const Params& p, int i, u32x4 (&qv)[8], u32x4 (&bv)[8]) {
    const bf16_t* BZ = (const bf16_t*)(p.ws + W_PB); const bf16_t* Q = (const bf16_t*)(p.ws + W_PC);
    const int c8 = (i & 127) * 8, row0 = (i >> 7) * 8;
#pragma unroll
    for (int t = T0; t < T1; ++t) { const size_t o = (size_t)(row0 + t) * 1024 + c8; qv[t] = *(const u32x4*)(Q + o); bv[t] = *(const u32x4*)(BZ + o); }
}
__device__ __forceinline__ void conv_finish(const Params& p, int i, const u32x4 (&qv)[8], const u32x4 (&bv)[8]) {
    const bf16_t* Q = (const bf16_t*)(p.ws + W_PC);
    bf16_t* YC = (bf16_t*)(p.ws + W_YAC) + (size_t)MT * 1024;
    const int c8 = (i & 127) * 8, chunk = i >> 7, row0 = chunk * 8;
    float w0[8], w1[8], w2[8], q2[8], q1[8];
#pragma unroll
    for (int j = 0; j < 8; ++j) { w0[j] = p.conv_w[c8 + j]; w1[j] = p.conv_w[1024 + c8 + j]; w2[j] = p.conv_w[2048 + c8 + j]; }
    const bool sample = row0 >= MP; const int t0 = sample ? 0 : (row0 & (SEQ - 1));
    if (sample) { const int b = (row0 - MP) >> 3; const float* sc = p.st_conv + (size_t)b * 2048 + c8;
#pragma unroll
        for (int j = 0; j < 8; ++j) { q2[j] = sc[j]; q1[j] = sc[1024 + j]; } }
    else if (t0 == 0) {
#pragma unroll
        for (int j = 0; j < 8; ++j) { q2[j] = 0.f; q1[j] = 0.f; } }
    else { unpack8(*(const u32x4*)(Q + (size_t)(row0 - 2) * 1024 + c8), q2); unpack8(*(const u32x4*)(Q + (size_t)(row0 - 1) * 1024 + c8), q1); }
#pragma unroll
    for (int t = 0; t < 8; ++t) {
        const size_t o = (size_t)(row0 + t) * 1024 + c8;
        float qq[8], bb[8], y[8];
        unpack8(qv[t], qq); unpack8(bv[t], bb);
#pragma unroll
        for (int j = 0; j < 8; ++j) { const float q = qq[j]; y[j] = bb[j] * (q2[j] * w0[j] + q1[j] * w1[j] + q * w2[j]); q2[j] = q1[j]; q1[j] = q; }
        u32x4 ov; ov[0] = cvt_pk_bf16(y[0], y[1]); ov[1] = cvt_pk_bf16(y[2], y[3]); ov[2] = cvt_pk_bf16(y[4], y[5]); ov[3] = cvt_pk_bf16(y[6], y[7]);
        *(u32x4*)(YC + o) = ov;
    }
    if (sample) { const int b = (row0 - MP) >> 3; float* d = p.out + O_CVS + (size_t)b * 2048 + c8;
#pragma unroll
        for (int j = 0; j < 8; ++j) { d[j] = q2[j]; d[1024 + j] = q1[j]; } }
    else if (t0 == SEQ - 8) { const int b = row0 >> 11; float* d = p.out + O_CVP + (size_t)b * 2048 + c8;
#pragma unroll
        for (int j = 0; j < 8; ++j) { d[j] = q2[j]; d[1024 + j] = q1[j]; } }
}

__device__ __forceinline__ void lds_barrier() { asm volatile("s_waitcnt lgkmcnt(0)" ::: "memory"); __builtin_amdgcn_s_barrier(); asm volatile("" ::: "memory"); }
__device__ __forceinline__ void phase_ssm(const Params& p, LAS unsigned char* lds) {
    const int tid = tid_opaque(), w = __builtin_amdgcn_readfirstlane(tid >> 6), lane = tid & 63, fr = lane & 15, fq = lane >> 4;
    const bf16_t* PU = (const bf16_t*)(p.ws + W_PU);
    LAS float* lam = (LAS float*)(lds + L_LAM);
    LAS float* S = (LAS float*)(lds + L_S);
    LAS float* E = (LAS float*)(lds + L_E);
    int g_cur = -1;
    const int ci = blockIdx.x * 512 + tid; bool cpref = false; u32x4 cq[8], cb[8];
    bool pref = false; u32x4 pua = {0u, 0u, 0u, 0u}, puc = {0u, 0u, 0u, 0u}; float ph0r[4] = {0.f, 0.f, 0.f, 0.f}, ph0i[4] = {0.f, 0.f, 0.f, 0.f};
    for (int unit = blockIdx.x; unit < 512; unit += gridDim.x) {
        const int g = unit & 63, sub = (unit >> 6) & 3; const bool sample = unit >= 256;
        if (g != g_cur) { ssm_setup(p, g, lds, w, fr, fq); g_cur = g; }
        const float l8r = lam[(8 * 64 + lane) * 2], l8i = lam[(8 * 64 + lane) * 2 + 1];
        if (!sample) {
            const int b = sub;
            if (!cpref && ci < CONV_ITEMS) { conv_issue<0, 4>(p, ci, cq, cb); cpref = true; }
            {
                const int nu = unit + gridDim.x; pref = nu >= 256 && nu < 512;
                if (pref) { const int gs = nu & 63, b0s = ((nu >> 6) & 3) * 32;
                    if (tid < 256) { const u32x4* src = (const u32x4*)(PU + ((size_t)gs * MT + MP + b0s * 8 + tid) * 16); pua = src[0]; puc = src[1]; }
#pragma unroll
                    for (int j = 0; j < 4; ++j) { const int e = tid + 512 * j, rr = e >> 6, pp = e & 63; const size_t o = ((size_t)(b0s + rr) * 64 + gs) * 64 + pp; ph0r[j] = p.st_re[o]; ph0i[j] = p.st_im[o]; } }
            }
            float l64r, l64i; { float ar = l8r * l8r - l8i * l8i, ai = 2.f * l8r * l8i; float br = ar * ar - ai * ai, bi = 2.f * ar * ai; l64r = br * br - bi * bi; l64i = 2.f * br * bi; }
            float hsr = 0.f, hsi = 0.f;
            u32x4 ua, uc; { const u32x4* src = (const u32x4*)(PU + ((size_t)g * MT + b * SEQ + tid) * 16); ua = src[0]; uc = src[1]; }

            for (int seg = 0; seg < 4; ++seg) {
                const int tok_base = b * SEQ + seg * 512;
                {
                    LAS unsigned char* d = lds + L_U + (tid >> 3) * 272 + (tid & 7) * 32;
                    *(LAS u32x4*)d = ua; *(LAS u32x4*)(d + 16) = uc;
                    if (seg < 3) { const u32x4* src = (const u32x4*)(PU + ((size_t)g * MT + tok_base + 512 + tid) * 16); ua = src[0]; uc = src[1]; }
                }
                lds_barrier();
                ssm_pass_a(lds, 4, w, fr, fq);
                lds_barrier();
                float xr[8], xi[8];
#pragma unroll
                for (int i = 0; i < 8; ++i) { xr[i] = S[(8 * w + i) * 128 + lane]; xi[i] = S[(8 * w + i) * 128 + 64 + lane]; }
                float hr = 0.f, hi = 0.f;
#pragma unroll
                for (int i = 0; i < 8; ++i) { const float sr = xr[i], si = xi[i]; xr[i] = hr; xi[i] = hi; const float nr = l8r * hr - l8i * hi + sr, ni = l8r * hi + l8i * hr + si; hr = nr; hi = ni; }
                E[w * 128 + lane] = hr; E[w * 128 + 64 + lane] = hi;
                lds_barrier();
                float cr = hsr, ci = hsi, myr = 0.f, myi = 0.f;
#pragma unroll
                for (int jj = 0; jj < 8; ++jj) { if (jj == w) { myr = cr; myi = ci; } const float er = E[jj * 128 + lane], ei = E[jj * 128 + 64 + lane];
                    const float nr = l64r * cr - l64i * ci + er, ni = l64r * ci + l64i * cr + ei; cr = nr; ci = ni; }
                hsr = cr; hsi = ci;
#pragma unroll
                for (int i = 0; i < 8; ++i) {
                    *(LAS bf16_t*)(lds + L_HIN + (8 * w + i) * 272 + lane * 2) = f2bf(xr[i] + myr); *(LAS bf16_t*)(lds + L_HIN + (8 * w + i) * 272 + (64 + lane) * 2) = f2bf(xi[i] + myi);
                    const float nr = l8r * myr - l8i * myi, ni = l8r * myi + l8i * myr; myr = nr; myi = ni;
                }
                lds_barrier();
                ssm_pass_c(p, lds, 4, w, fr, fq, g, tok_base);
                lds_barrier();
            }
            if (w == 0) { p.out[O_SRP + ((size_t)b * 64 + g) * 64 + lane] = hsr; p.out[O_SIP + ((size_t)b * 64 + g) * 64 + lane] = hsi; }
        } else {
            const int b0 = sub * 32, tok_base = MP + b0 * 8;
            float h0r[4], h0i[4];
            if (pref) {
#pragma unroll
                for (int j = 0; j < 4; ++j) { h0r[j] = ph0r[j]; h0i[j] = ph0i[j]; }
            } else {
                if (tid < 256) { const u32x4* src = (const u32x4*)(PU + ((size_t)g * MT + tok_base + tid) * 16); pua = src[0]; puc = src[1]; }
#pragma unroll
                for (int j = 0; j < 4; ++j) {
                    const int e = tid + 512 * j, rr = e >> 6, pp = e & 63;
                    const size_t o = ((size_t)(b0 + rr) * 64 + g) * 64 + pp;
                    h0r[j] = p.st_re[o]; h0i[j] = p.st_im[o];
                }
            }
            pref = false;
            if (tid < 256) { LAS unsigned char* d = lds + L_U + (tid >> 3) * 272 + (tid & 7) * 32; *(LAS u32x4*)d = pua; *(LAS u32x4*)(d + 16) = puc; }
#pragma unroll
            for (int j = 0; j < 4; ++j) {
                const int e = tid + 512 * j, rr = e >> 6, pp = e & 63;
                *(LAS bf16_t*)(lds + L_HIN + rr * 272 + pp * 2) = f2bf(h0r[j]); *(LAS bf16_t*)(lds + L_HIN + rr * 272 + (64 + pp) * 2) = f2bf(h0i[j]);
            }
            __syncthreads();
            ssm_pass_a(lds, 2, w, fr, fq);
            __syncthreads();
#pragma unroll
            for (int j = 0; j < 4; ++j) {
                const int e = tid + 512 * j, rr = e >> 6, pp = e & 63;
                const size_t o = ((size_t)(b0 + rr) * 64 + g) * 64 + pp;
                const float sr = S[rr * 128 + pp], si = S[rr * 128 + 64 + pp];
                p.out[O_SRS + o] = l8r * h0r[j] - l8i * h0i[j] + sr; p.out[O_SIS + o] = l8r * h0i[j] + l8i * h0r[j] + si;
            }
            ssm_pass_c(p, lds, 2, w, fr, fq, g, tok_base);
            __syncthreads();
        }
    }
    if (ci < CONV_ITEMS) { if (!cpref) conv_issue<0, 4>(p, ci, cq, cb); conv_issue<4, 8>(p, ci, cq, cb); conv_finish(p, ci, cq, cb); }
    { const int G = gridDim.x, rest = CONV_ITEMS - G * 512;
      if (rest > 0) { const int per = (rest + G - 1) / G;
        for (int k = tid; k < per; k += 512) { const int i = G * 512 + blockIdx.x * per + k; if (i < CONV_ITEMS) { conv_issue<0, 8>(p, i, cq, cb); conv_finish(p, i, cq, cb); } } } }
}

__device__ __forceinline__ void phase_ln(const Params& p) {
    const int tl = tid_opaque(), lane = tl & 63, wv = tl >> 6;
    for (int row = blockIdx.x * 8 + wv; row < MT; row += gridDim.x * 8) {
        float* r = p.out + (size_t)row * D_MODEL;
        f32x4 v[8]; float s = 0.f;
#pragma unroll
        for (int j = 0; j < 8; ++j) { v[j] = *(const f32x4*)(r + j * 256 + lane * 4); s += v[j][0] + v[j][1] + v[j][2] + v[j][3]; }
#pragma unroll
        for (int o = 32; o > 0; o >>= 1) s += __shfl_xor(s, o);
        const float mu = s * (1.0f / D_MODEL);
        float q = 0.f;
#pragma unroll
        for (int j = 0; j < 8; ++j) { v[j] = v[j] - mu; q += v[j][0] * v[j][0] + v[j][1] * v[j][1] + v[j][2] * v[j][2] + v[j][3] * v[j][3]; }
#pragma unroll
        for (int o = 32; o > 0; o >>= 1) q += __shfl_xor(q, o);
        const float rs = rsqrtf(q * (1.0f / D_MODEL) + LN_EPS);
#pragma unroll
        for (int j = 0; j < 8; ++j) { const f32x4 gg = *(const f32x4*)(p.ln_g + j * 256 + lane * 4), bb = *(const f32x4*)(p.ln_b + j * 256 + lane * 4);
            *(f32x4*)(r + j * 256 + lane * 4) = v[j] * rs * gg + bb; }
    }
}

namespace flow {
using namespace pg8;
enum { T_GLU = 0, T_C = 1, T_A = 2, T_O1 = 3, T_O2 = 4 };
struct FUnit { int type, pm, pn, h; };
constexpr int NJ_GLU = 144, NJ_PAIR = 288, NJ_OF = 224, NJ_OH = 128, NJOBS = NJ_GLU + NJ_PAIR + NJ_OF + NJ_OH;
constexpr int CTL_QHEAD = 0, CTL_PRE = 64, CTL_LNQ = 64 * 120, NJ_LN = 576;
__host__ __device__ constexpr int CTL_G(int pm) { return 64 * (2 + pm); }
__host__ __device__ constexpr int CTL_M(int pm) { return 64 * (40 + pm); }
__host__ __device__ constexpr int CTL_R(int pm) { return 64 * (80 + pm); }
constexpr size_t HSZ = (size_t)MT * 1024 * 2, WSZ = (size_t)2048 * 1024 * 2, TSTEP = (size_t)256 * 1024 * 2;
__device__ __forceinline__ const char* unitA(const unsigned char* ws, const FUnit& u) {
    const size_t off = u.type == T_GLU ? W_G1 : u.type == T_C ? W_YAC + HSZ : u.type == T_A ? W_YAC : u.type == T_O1 ? W_MG : W_MG + HSZ;
    return (const char*)ws + off + (size_t)u.pm * TSTEP + (u.h == 2 ? TSTEP / 2 : 0);
}
__device__ __forceinline__ const char* unitB(const unsigned char* ws, const FUnit& u) {
    const size_t off = u.type == T_GLU ? W_WGLUT : u.type == T_C ? W_WOACT + WSZ : u.type == T_A ? W_WOACT : u.type == T_O1 ? W_WOT : W_WOT + WSZ;
    return (const char*)ws + off + (size_t)u.pn * TSTEP;
}
__device__ __forceinline__ void st_wt(__amdgpu_buffer_rsrc_t r, size_t byte_off, u32x4 v) { __builtin_amdgcn_raw_buffer_store_b128(v, r, (unsigned)byte_off, 0, 16); }

__device__ __forceinline__ void epilogue(const Params& p, const f32x4 (&acc)[2][2][4][2], const FUnit& u, int wr, int wc, int fr, int fq) {
    unsigned char* ws = p.ws;
    if (u.type == T_GLU) {
        const bf16_t* G1 = (const bf16_t*)(ws + W_G1); const bf16_t* ZA = (const bf16_t*)(ws + W_PZA);
        const __amdgpu_buffer_rsrc_t rs = __builtin_amdgcn_make_buffer_rsrc(ws + W_YAC, 0, (int)HSZ, 0x00020000);
        EPI_HALF_BEGIN
            u32x4 gv[4][2], zv[4][2];
            EPI_MB_LOOP { const size_t o = (size_t)(u.pm * 256 + EPI_RL) * 1024 + u.pn * 256 + EPI_CL; gv[m][bj] = *(const u32x4*)(G1 + o); zv[m][bj] = *(const u32x4*)(ZA + o); }
            EPI_MB_LOOP { const size_t o = (size_t)(u.pm * 256 + EPI_RL) * 1024 + u.pn * 256 + EPI_CL;
                const f32x4 v0 = acc[ai][bj][m][0], v1 = acc[ai][bj][m][1]; const u32x4 g = gv[m][bj], z = zv[m][bj];
                f32x4 a, b;
                a[0] = bf_lo(g[0]) * sigmoidf_(v0[0]) * bf_lo(z[0]); a[1] = bf_hi(g[0]) * sigmoidf_(v0[1]) * bf_hi(z[0]);
                a[2] = bf_lo(g[1]) * sigmoidf_(v0[2]) * bf_lo(z[1]); a[3] = bf_hi(g[1]) * sigmoidf_(v0[3]) * bf_hi(z[1]);
                b[0] = bf_lo(g[2]) * sigmoidf_(v1[0]) * bf_lo(z[2]); b[1] = bf_hi(g[2]) * sigmoidf_(v1[1]) * bf_hi(z[2]);
                b[2] = bf_lo(g[3]) * sigmoidf_(v1[2]) * bf_lo(z[3]); b[3] = bf_hi(g[3]) * sigmoidf_(v1[3]) * bf_hi(z[3]);
                st_wt(rs, o * 2, pack8(a, b)); }
        EPI_HALF_END
    } else if (u.type == T_A) {
        const bf16_t* SA = (const bf16_t*)(ws + W_PGA);
        const __amdgpu_buffer_rsrc_t rs = __builtin_amdgcn_make_buffer_rsrc(ws + W_MG, 0, (int)(2 * HSZ), 0x00020000);
        const size_t hoff = (size_t)(u.pn >> 2) * HSZ;
        u32x4 gv[2][4][2];
        EPI_HALF_BEGIN
            EPI_MB_LOOP { const size_t o = (size_t)(u.pm * 256 + EPI_RL) * 2048 + u.pn * 256 + EPI_CL; gv[ai][m][bj] = *(const u32x4*)(SA + o); }
        EPI_HALF_END
        EPI_HALF_BEGIN
            EPI_MB_LOOP { const size_t o = (size_t)(u.pm * 256 + EPI_RL) * 1024 + (u.pn & 3) * 256 + EPI_CL;
                const f32x4 v0 = acc[ai][bj][m][0], v1 = acc[ai][bj][m][1]; const u32x4 g = gv[ai][m][bj];
                f32x4 a, b;
                a[0] = bf_lo(g[0]) * v0[0]; a[1] = bf_hi(g[0]) * v0[1]; a[2] = bf_lo(g[1]) * v0[2]; a[3] = bf_hi(g[1]) * v0[3];
                b[0] = bf_lo(g[2]) * v1[0]; b[1] = bf_hi(g[2]) * v1[1]; b[2] = bf_lo(g[3]) * v1[2]; b[3] = bf_hi(g[3]) * v1[3];
                st_wt(rs, hoff + o * 2, pack8(a, b)); }
        EPI_HALF_END
    } else {
        const int rbase = u.pm * 256 + (u.h == 2 ? 128 : 0);
        const bf16_t* XB = (const bf16_t*)(ws + W_XB);
        const __amdgpu_buffer_rsrc_t rsr = __builtin_amdgcn_make_buffer_rsrc(ws + W_PH, 0, (int)(2 * HSZ), 0x00020000);
        u32x4 xv[2][4][2];
        EPI_HALF_BEGIN
            if (u.h != 0 && ai == 1) break;
            EPI_MB_LOOP { const size_t o = (size_t)(rbase + EPI_RL) * D_MODEL + u.pn * 256 + EPI_CL; xv[ai][m][bj] = *(const u32x4*)(XB + o); }
        EPI_HALF_END
        EPI_HALF_BEGIN
            if (u.h != 0 && ai == 1) break;
            EPI_MB_LOOP { const size_t o = (size_t)(rbase + EPI_RL) * D_MODEL + u.pn * 256 + EPI_CL;
                const u32x4 x = xv[ai][m][bj]; const f32x4 v0 = acc[ai][bj][m][0], v1 = acc[ai][bj][m][1];
                f32x4 a, b;
                a[0] = bf_lo(x[0]) * DN_ALPHA + v0[0]; a[1] = bf_hi(x[0]) * DN_ALPHA + v0[1]; a[2] = bf_lo(x[1]) * DN_ALPHA + v0[2]; a[3] = bf_hi(x[1]) * DN_ALPHA + v0[3];
                b[0] = bf_lo(x[2]) * DN_ALPHA + v1[0]; b[1] = bf_hi(x[2]) * DN_ALPHA + v1[1]; b[2] = bf_lo(x[3]) * DN_ALPHA + v1[2]; b[3] = bf_hi(x[3]) * DN_ALPHA + v1[3];
                st_wt(rsr, o * 2, pack8(a, b)); }
        EPI_HALF_END
    }
}

__device__ __forceinline__ void ln_rows(const Params& p, int row0, int nrows, int lane) {
    const bf16_t* R = (const bf16_t*)(p.ws + W_PH);
    for (int row = row0; row < row0 + nrows; ++row) {
        const bf16_t* r = R + (size_t)row * D_MODEL;
        float v[32]; float s = 0.f;
#pragma unroll
        for (int j = 0; j < 4; ++j) { const u32x4 w = *(const u32x4*)(r + j * 512 + lane * 8);
#pragma unroll
            for (int q = 0; q < 4; ++q) { v[j * 8 + 2 * q] = bf_lo(w[q]); v[j * 8 + 2 * q + 1] = bf_hi(w[q]); } }
#pragma unroll
        for (int j = 0; j < 32; ++j) s += v[j];
#pragma unroll
        for (int o = 32; o > 0; o >>= 1) s += __shfl_xor(s, o);
        const float mu = s * (1.0f / D_MODEL);
        float q2 = 0.f;
#pragma unroll
        for (int j = 0; j < 32; ++j) { v[j] -= mu; q2 += v[j] * v[j]; }
#pragma unroll
        for (int o = 32; o > 0; o >>= 1) q2 += __shfl_xor(q2, o);
        const float rs = rsqrtf(q2 * (1.0f / D_MODEL) + LN_EPS);
        float* o = p.out + (size_t)row * D_MODEL;
#pragma unroll
        for (int j = 0; j < 4; ++j)
#pragma unroll
            for (int h = 0; h < 2; ++h) { const int c = j * 512 + lane * 8 + h * 4; const f32x4 gg = *(const f32x4*)(p.ln_g + c), bb = *(const f32x4*)(p.ln_b + c);
                f32x4 y; y[0] = v[j * 8 + h * 4] * rs * gg[0] + bb[0]; y[1] = v[j * 8 + h * 4 + 1] * rs * gg[1] + bb[1]; y[2] = v[j * 8 + h * 4 + 2] * rs * gg[2] + bb[2]; y[3] = v[j * 8 + h * 4 + 3] * rs * gg[3] + bb[3];
                *(f32x4*)(o + c) = y; }
    }
}

__device__ __forceinline__ void gemm_flow(LAS unsigned char* lds, const Params& p, unsigned npre) {
    const int tid = tid_opaque(), wid = __builtin_amdgcn_readfirstlane(tid >> 6), lane = tid & 63, wr = wid >> 2, wc = wid & 3, fr = lane & 15, fq = lane >> 4;
    constexpr int K = 1024, nt = K / BK;
    unsigned* ctl = (unsigned*)(p.ws + W_CTL);
    volatile LAS unsigned* slot = (volatile LAS unsigned*)(lds + LDS_BYTES - 32);
    unsigned voffA[2], voffB[2];
#pragma unroll
    for (int i = 0; i < 2; ++i) { int R, C; stage_rc(tid * 16 + i * 8192, R, C); const int Rb = (R & ~31) + perm32(R & 31);
        voffA[i] = (unsigned)(R * K + C) * 2u; voffB[i] = (unsigned)(Rb * K + C) * 2u; }
    const size_t kstep = (size_t)(BK * 2);
    const size_t hstep = (size_t)HALF * K * 2;
    const unsigned ldsw = (unsigned)wid * 1024u;
    const int aoff = lds_byte(wr * 64 + fr, fq * 8), boff = lds_byte(wc * 32 + fr, fq * 8);
#define PG8_SA(b, h) (((b) * 2 + (h)) * HTB)
#define PG8_SB(b, h) ((4 + (b) * 2 + (h)) * HTB)
#define PG8_STAGE(bufoff, gbase, voff) do { _Pragma("unroll") for (int _i = 0; _i < 2; ++_i) \
        __builtin_amdgcn_global_load_lds((const unsigned*)((const char*)(gbase) + (voff)[_i]), (LAS unsigned*)(lds + (bufoff) + ldsw + _i * 8192), 16, 0, 0); } while (0)
#define PG8_LDA(dst, b, h) do { _Pragma("unroll") for (int m = 0; m < 4; ++m) _Pragma("unroll") for (int k = 0; k < 2; ++k) dst[m][k] = *(const LAS bf16x8*)(lds + PG8_SA(b, h) + aoff + m * 2048 + k * 1024); } while (0)
#define PG8_LDB(dst, b, h) do { _Pragma("unroll") for (int n = 0; n < 2; ++n) _Pragma("unroll") for (int k = 0; k < 2; ++k) dst[n][k] = *(const LAS bf16x8*)(lds + PG8_SB(b, h) + boff + n * 2048 + k * 1024); } while (0)
#define PG8_MMA(ai, bj, At, Bt) do { __builtin_amdgcn_s_setprio(1); _Pragma("unroll") for (int m = 0; m < 4; ++m) _Pragma("unroll") for (int n = 0; n < 2; ++n) _Pragma("unroll") for (int k = 0; k < 2; ++k) \
        acc[ai][bj][m][n] = __builtin_amdgcn_mfma_f32_16x16x32_bf16(Bt[n][k], At[m][k], acc[ai][bj][m][n], 0, 0, 0); __builtin_amdgcn_s_setprio(0); } while (0)
#define PG8_WAIT_V(n) asm volatile("s_waitcnt vmcnt(" #n ")" ::: "memory")
#define PG8_WAIT_L(n) asm volatile("s_waitcnt lgkmcnt(" #n ")" ::: "memory")
#define PG8_BAR __builtin_amdgcn_s_barrier()
#define PG8_SCHED __builtin_amdgcn_sched_barrier(0)
    bool pend = false;
#define FLOW_NEXT(prevu, outu, has) do { \
        if (pend) { outu.type = prevu.type + 1; outu.pm = prevu.pm; outu.pn = prevu.pn; outu.h = prevu.h; pend = false; has = true; } \
        else { if (tid == 0) { const unsigned _j = __hip_atomic_fetch_add(ctl + CTL_QHEAD, 1u, __ATOMIC_RELAXED, __HIP_MEMORY_SCOPE_AGENT); *slot = _j; asm volatile("s_waitcnt lgkmcnt(0)" ::: "memory"); } \
            asm volatile("" ::: "memory"); PG8_BAR; asm volatile("" ::: "memory"); \
            const int _jb = __builtin_amdgcn_readfirstlane((int)*slot); \
            if (_jb >= NJOBS) has = false; \
            else { has = true; outu.h = 0; \
                if (_jb < NJ_GLU) { outu.type = T_GLU; outu.pm = _jb >> 2; outu.pn = _jb & 3; } \
                else if (_jb < NJ_GLU + NJ_PAIR) { const int _q = _jb - NJ_GLU; outu.type = T_C; outu.pm = _q >> 3; outu.pn = _q & 7; pend = true; } \
                else { const int _q = _jb - NJ_GLU - NJ_PAIR; outu.type = T_O1; pend = true; \
                    if (_q < NJ_OF) { outu.pm = _q >> 3; outu.pn = _q & 7; } \
                    else { const int _r = _q - NJ_OF, _t = _r >> 1; outu.pm = (NJ_OF >> 3) + (_t >> 3); outu.pn = _t & 7; outu.h = 1 + (_r & 1); } } } } } while (0)
#define FLOW_READY(uu) do { \
        if ((uu.type == T_C && npre != 0u) || uu.type == T_A || uu.type == T_O1) { \
            if (wid == 0) { const unsigned* _c = ctl + (uu.type == T_C ? CTL_PRE : uu.type == T_A ? CTL_G(uu.pm) : CTL_M(uu.pm)); const unsigned _need = uu.type == T_C ? npre : uu.type == T_A ? 32u : 64u; \
                unsigned _polls = 0; while ((unsigned)__builtin_amdgcn_readfirstlane(__hip_atomic_load(_c, __ATOMIC_RELAXED, __HIP_MEMORY_SCOPE_AGENT)) < _need) { __builtin_amdgcn_s_sleep(2); if (++_polls > (1u << 20)) break; } \
                asm volatile("s_waitcnt vmcnt(0)" ::: "memory"); } \
            asm volatile("" ::: "memory"); PG8_BAR; asm volatile("" ::: "memory"); } } while (0)
#define FLOW_DONE(uu) do { \
        if (uu.type == T_GLU || uu.type == T_A || uu.type == T_O2) { asm volatile("s_waitcnt vmcnt(0)" ::: "memory"); \
            if (lane == 0) (void)__hip_atomic_fetch_add(ctl + (uu.type == T_GLU ? CTL_G(uu.pm) : uu.type == T_A ? CTL_M(uu.pm) : CTL_R(uu.pm)), 1u, __ATOMIC_RELAXED, __HIP_MEMORY_SCOPE_AGENT); } } while (0)
    FUnit cur, nxt; bool has_cur;
    cur.type = 0; cur.pm = 0; cur.pn = 0; cur.h = 0; nxt = cur;
    FLOW_NEXT(cur, cur, has_cur);
    if (has_cur) {
    f32x4 acc[2][2][4][2];
#pragma unroll
    for (int a = 0; a < 2; ++a)
#pragma unroll
        for (int b = 0; b < 2; ++b)
#pragma unroll
            for (int m = 0; m < 4; ++m)
#pragma unroll
                for (int n = 0; n < 2; ++n) acc[a][b][m][n] = (f32x4){0.f, 0.f, 0.f, 0.f};
    bf16x8 At[4][2], B0[2][2], B1[2][2];
    for (;;) {
        const char* cA = unitA(p.ws, cur); const char* cB = unitB(p.ws, cur);
        FLOW_READY(cur);
        PG8_STAGE(PG8_SB(0, 0), cB, voffB); PG8_STAGE(PG8_SA(0, 0), cA, voffA); PG8_STAGE(PG8_SB(0, 1), cB + hstep, voffB); PG8_STAGE(PG8_SA(0, 1), cA + hstep, voffA);
        if (wr == 1) PG8_BAR;
        PG8_WAIT_V(4); PG8_BAR;
        PG8_STAGE(PG8_SB(1, 0), cB + kstep, voffB); PG8_STAGE(PG8_SA(1, 0), cA + kstep, voffA); PG8_STAGE(PG8_SB(1, 1), cB + hstep + kstep, voffB);
        PG8_WAIT_V(6); PG8_BAR;
        bool has_next;
        for (;;) {
            FLOW_NEXT(cur, nxt, has_next);
            const bool chain = has_next && nxt.type != T_O1;
            const bool full = cur.h == 0;
            const char* nA = chain ? unitA(p.ws, nxt) : cA; const char* nB = chain ? unitB(p.ws, nxt) : cB;
            for (int t = 0; t < nt; t += 2) {
                const bool last = (t == nt - 2);
                const char* a1 = cA + (size_t)(t + 1) * kstep;
                const char* a2 = last ? nA : cA + (size_t)(t + 2) * kstep; const char* b2 = last ? nB : cB + (size_t)(t + 2) * kstep;
                const char* a3 = a2 + kstep; const char* b3 = b2 + kstep;
                if (last && chain) FLOW_READY(nxt);
                PG8_LDB(B0, 0, 0); PG8_SCHED; PG8_LDA(At, 0, 0); PG8_STAGE(PG8_SA(1, 1), a1 + hstep, voffA);
                PG8_WAIT_L(8); PG8_BAR; PG8_WAIT_L(0); PG8_MMA(0, 0, At, B0); PG8_BAR; PG8_SCHED;
                PG8_LDB(B1, 0, 1); PG8_STAGE(PG8_SB(0, 0), b2, voffB);
                PG8_BAR; PG8_WAIT_L(0); PG8_MMA(0, 1, At, B1); PG8_BAR;
                PG8_LDA(At, 0, 1); PG8_STAGE(PG8_SA(0, 0), a2, voffA);
                PG8_BAR; PG8_WAIT_L(0); if (full) PG8_MMA(1, 0, At, B0); PG8_BAR; PG8_SCHED;
                PG8_STAGE(PG8_SB(0, 1), b2 + hstep, voffB);
                PG8_WAIT_V(6); PG8_BAR; if (full) PG8_MMA(1, 1, At, B1); PG8_BAR;
                PG8_LDB(B0, 1, 0); PG8_SCHED; PG8_LDA(At, 1, 0); PG8_STAGE(PG8_SA(0, 1), a2 + hstep, voffA);
                PG8_WAIT_L(8); PG8_BAR; PG8_WAIT_L(0); PG8_MMA(0, 0, At, B0); PG8_BAR; PG8_SCHED;
                PG8_LDB(B1, 1, 1); PG8_STAGE(PG8_SB(1, 0), b3, voffB);
                PG8_BAR; PG8_WAIT_L(0); PG8_MMA(0, 1, At, B1); PG8_BAR;
                PG8_LDA(At, 1, 1); PG8_STAGE(PG8_SA(1, 0), a3, voffA);
                PG8_BAR; PG8_WAIT_L(0); if (full) PG8_MMA(1, 0, At, B0); PG8_BAR; PG8_SCHED;
                PG8_STAGE(PG8_SB(1, 1), b3 + hstep, voffB);
                PG8_WAIT_V(6); PG8_BAR; if (full) PG8_MMA(1, 1, At, B1); PG8_BAR;
            }
            if (cur.type != T_C && cur.type != T_O1) { epilogue(p, acc, cur, wr, wc, fr, fq); FLOW_DONE(cur); }
            if (!chain) break;
            {
                const bool isTC = cur.type == T_C;
                const unsigned kbits = (nxt.type == T_O2) ? 0x3F803F80u : 0u;
                const bf16_t* RT = (const bf16_t*)(p.ws + W_PGC);
                u32x4 gv[2][4][2];
                EPI_HALF_BEGIN
                    if (isTC) { EPI_MB_LOOP { const size_t o = (size_t)(cur.pm * 256 + EPI_RL) * 2048 + cur.pn * 256 + EPI_CL; gv[ai][m][bj] = *(const u32x4*)(RT + o); } }
                    else { EPI_MB_LOOP gv[ai][m][bj] = (u32x4){kbits, kbits, kbits, kbits}; }
                EPI_HALF_END
                EPI_HALF_BEGIN
                    EPI_MB_LOOP { const u32x4 g = gv[ai][m][bj];
                        acc[ai][bj][m][0][0] *= bf_lo(g[0]); acc[ai][bj][m][0][1] *= bf_hi(g[0]); acc[ai][bj][m][0][2] *= bf_lo(g[1]); acc[ai][bj][m][0][3] *= bf_hi(g[1]);
                        acc[ai][bj][m][1][0] *= bf_lo(g[2]); acc[ai][bj][m][1][1] *= bf_hi(g[2]); acc[ai][bj][m][1][2] *= bf_lo(g[3]); acc[ai][bj][m][1][3] *= bf_hi(g[3]); }
                EPI_HALF_END
            }
            cur = nxt; cA = nA; cB = nB;
        }
        PG8_WAIT_V(0);
        if (wr == 0) PG8_BAR;
        PG8_BAR;
        if (!has_next) break;
#pragma unroll
        for (int a = 0; a < 2; ++a)
#pragma unroll
            for (int b = 0; b < 2; ++b)
#pragma unroll
                for (int m = 0; m < 4; ++m)
#pragma unroll
                    for (int n = 0; n < 2; ++n) acc[a][b][m][n] = (f32x4){0.f, 0.f, 0.f, 0.f};
        cur = nxt;
    }
    }
    __syncthreads();
    for (;;) {
        if (tid == 0) { const unsigned _j = __hip_atomic_fetch_add(ctl + CTL_LNQ, 1u, __ATOMIC_RELAXED, __HIP_MEMORY_SCOPE_AGENT); *slot = _j; }
        __syncthreads();
        const int j = __builtin_amdgcn_readfirstlane((int)*slot);
        if (j >= NJ_LN) break;
        const int pm = j >> 4, part = j & 15;
        if (wid == 0) { const unsigned* _c = ctl + CTL_R(pm); const unsigned _need = pm < (NJ_OF >> 3) ? 64u : 128u;
            unsigned _polls = 0; while ((unsigned)__builtin_amdgcn_readfirstlane(__hip_atomic_load(_c, __ATOMIC_RELAXED, __HIP_MEMORY_SCOPE_AGENT)) < _need) { __builtin_amdgcn_s_sleep(16); if (++_polls > (1u << 20)) break; }
            asm volatile("s_waitcnt vmcnt(0)" ::: "memory"); }
        __syncthreads();
        ln_rows(p, pm * 256 + part * 16 + wid * 2, 2, lane);
    }
#undef FLOW_NEXT
#undef FLOW_READY
#undef FLOW_DONE
#undef PG8_SA
#undef PG8_SB
#undef PG8_STAGE
#undef PG8_LDA
#undef PG8_LDB
#undef PG8_MMA
#undef PG8_WAIT_V
#undef PG8_WAIT_L
#undef PG8_BAR
#undef PG8_SCHED
}
}

__device__ __forceinline__ void run_phase(const Params& p, LAS unsigned char* lds, int ph) {
    const int G = gridDim.x, c = blockIdx.x;
    if (ph == 0) { phase_convert(p, lds); }
    else if (ph == 1) { pg8::StaticOrder S; S.init(36, 40, G, c); pg8::Gemm g{(const bf16_t*)(p.ws + W_XB), (const bf16_t*)(p.ws + W_WINT), 2048}; EpiProj E{p.ws}; pg8::gemm_phase(lds, g, S, E);
        const int rem = 1440 % G; if (rem == 0) phase_convert_late(p, lds, c, G); else if (c >= rem) phase_convert_late(p, lds, c - rem, G - rem); }
    else if (ph == 2) { phase_ssm(p, lds); }
    else if (ph == 3) {
        const int npre = 0;
        flow::gemm_flow(lds, p, (unsigned)npre);
    }
    else { phase_ln(p); }
}

extern __shared__ __attribute__((aligned(16))) unsigned char dyn_lds[];

#if MK_SINGLE
__global__ __launch_bounds__(512, 2) void mega_kernel(Params p) {
    LAS unsigned char* lds = (LAS unsigned char*)dyn_lds;
    if (__builtin_expect(p.ws == nullptr, 0)) cg::this_grid().sync();
    volatile LAS unsigned* st = (volatile LAS unsigned*)(lds + LDS_BYTES - 16);
    if (threadIdx.x == 0) { st[0] = 0u; st[1] = 0u; st[2] = 0u; st[3] = 0u; }
    __syncthreads();
    const XcdBarrier xb = xcd_barrier_post((unsigned*)(p.ws + W_BAR), st);
#ifndef PROBE_DUP
#define PROBE_DUP -1
#endif
#ifndef PROBE_SYNCS
#define PROBE_SYNCS 0
#endif
#define RUNP(k) do { run_phase(p, lds, k); xcd_barrier(xb); if (PROBE_DUP == k) { run_phase(p, lds, k); xcd_barrier(xb); } for (int _s = 0; _s < PROBE_SYNCS; ++_s) xcd_barrier(xb); } while (0)
    RUNP(0); RUNP(1); RUNP(2);
    run_phase(p, lds, 3);
}
#endif
template <int PH> __global__ __launch_bounds__(512, 2) void phase_kernel(Params p) {
    LAS unsigned char* lds = (LAS unsigned char*)dyn_lds;
    run_phase(p, lds, PH);
}

extern "C" void kernel_launch(void* const* d_in, const int* in_sizes, int n_in, void* d_out, int out_size, void* d_ws, size_t ws_size, hipStream_t stream) {
    Params p{};
    p.x_prompt = (const float*)d_in[0]; p.x_sample = (const float*)d_in[1]; p.st_re = (const float*)d_in[2]; p.st_im = (const float*)d_in[3]; p.st_conv = (const float*)d_in[4];
    p.w_in = (const float*)d_in[5]; p.a_re = (const float*)d_in[6]; p.a_im = (const float*)d_in[7]; p.log_dt = (const float*)d_in[8]; p.b_re = (const float*)d_in[9]; p.b_im = (const float*)d_in[10];
    p.c_re = (const float*)d_in[11]; p.c_im = (const float*)d_in[12]; p.ssm_d = (const float*)d_in[13]; p.w_glu = (const float*)d_in[14]; p.w_out_a = (const float*)d_in[15]; p.conv_w = (const float*)d_in[16];
    p.w_out_c = (const float*)d_in[17]; p.w_o = (const float*)d_in[18]; p.ln_g = (const float*)d_in[19]; p.ln_b = (const float*)d_in[20];
    p.out = (float*)d_out; p.ws = (unsigned char*)d_ws;
    if (ws_size < W_END) { fprintf(stderr, "workspace too small: %zu < %zu\n", ws_size, (size_t)W_END); return; }
#if MK_SINGLE
    static int grid_blocks = 0;
    if (!grid_blocks) {
        int dev = 0, cus = 0, per_cu = 0;
        hipGetDevice(&dev);
        hipDeviceGetAttribute(&cus, hipDeviceAttributeMultiprocessorCount, dev);
        hipFuncSetAttribute((const void*)mega_kernel, hipFuncAttributeMaxDynamicSharedMemorySize, LDS_BYTES);
        hipOccupancyMaxActiveBlocksPerMultiprocessor(&per_cu, mega_kernel, 512, LDS_BYTES);
        if (per_cu < 1) per_cu = 1;
        grid_blocks = cus * per_cu; if (grid_blocks > 256) grid_blocks = 256;
    }
    (void)hipMemsetAsync(p.ws + W_BAR, 0, 16384 + 32768, stream);
    void* args[] = {&p};
    hipError_t e = hipLaunchCooperativeKernel((const void*)mega_kernel, dim3(grid_blocks), dim3(512), args, LDS_BYTES, stream);
    if (e != hipSuccess) fprintf(stderr, "cooperative launch failed: %s (grid %d)\n", hipGetErrorString(e), grid_blocks);
#else
    static bool attr = false;
    if (!attr) {
        hipFuncSetAttribute((const void*)phase_kernel<0>, hipFuncAttributeMaxDynamicSharedMemorySize, LDS_BYTES); hipFuncSetAttribute((const void*)phase_kernel<1>, hipFuncAttributeMaxDynamicSharedMemorySize, LDS_BYTES);
        hipFuncSetAttribute((const void*)phase_kernel<2>, hipFuncAttributeMaxDynamicSharedMemorySize, LDS_BYTES); hipFuncSetAttribute((const void*)phase_kernel<3>, hipFuncAttributeMaxDynamicSharedMemorySize, LDS_BYTES);
        hipFuncSetAttribute((const void*)phase_kernel<4>, hipFuncAttributeMaxDynamicSharedMemorySize, LDS_BYTES); hipFuncSetAttribute((const void*)phase_kernel<5>, hipFuncAttributeMaxDynamicSharedMemorySize, LDS_BYTES);
        hipFuncSetAttribute((const void*)phase_kernel<6>, hipFuncAttributeMaxDynamicSharedMemorySize, LDS_BYTES); attr = true;
    }
    phase_kernel<0><<<256, 512, LDS_BYTES, stream>>>(p);
    phase_kernel<1><<<256, 512, LDS_BYTES, stream>>>(p);
    phase_kernel<2><<<256, 512, LDS_BYTES, stream>>>(p);
    phase_kernel<3><<<256, 512, LDS_BYTES, stream>>>(p);
    phase_kernel<4><<<256, 512, LDS_BYTES, stream>>>(p);
    phase_kernel<5><<<256, 512, LDS_BYTES, stream>>>(p);
    phase_kernel<6><<<256, 512, LDS_BYTES, stream>>>(p);
#endif
}
```

```cpp
#include <hip/hip_runtime.h>
#include <hip/hip_cooperative_groups.h>
#include <cstdio>
namespace cg = cooperative_groups;

#ifndef MK_SINGLE
#define MK_SINGLE 1
#endif

#define LAS __attribute__((address_space(3)))
typedef unsigned short bf16_t;
typedef short bf16x8 __attribute__((ext_vector_type(8)));
typedef float f32x4 __attribute__((ext_vector_type(4)));
typedef unsigned u32x4 __attribute__((ext_vector_type(4)));
typedef unsigned u32x2 __attribute__((ext_vector_type(2)));

constexpr int D_MODEL = 2048, MP = 8192, MS = 1024, MT = MP + MS, SEQ = 2048, NIN = 10240;
constexpr int DS = 1024, NG = 64;
constexpr float DN_ALPHA = 1.189207115002721f;
constexpr float LN_EPS = 1e-5f;
constexpr size_t O_Y = 0, O_SRP = (size_t)MT * D_MODEL, O_SIP = O_SRP + 16384, O_CVP = O_SIP + 16384, O_SRS = O_CVP + 8192, O_SIS = O_SRS + 524288, O_CVS = O_SIS + 524288;
constexpr size_t SZ_X = (size_t)MT * D_MODEL * 2;
constexpr size_t SZ_H = (size_t)MT * DS * 2;
constexpr size_t W_XB = 0;
constexpr size_t W_WINT = W_XB + SZ_X;
constexpr size_t W_WGLUT = W_WINT + (size_t)NIN * D_MODEL * 2;
constexpr size_t W_WOACT = W_WGLUT + (size_t)DS * DS * 2;
constexpr size_t W_WOT = W_WOACT + (size_t)2 * D_MODEL * DS * 2;
constexpr size_t W_PU = W_WOT + (size_t)D_MODEL * D_MODEL * 2;
constexpr size_t W_PZA = W_PU + SZ_H;
constexpr size_t W_PB = W_PZA + SZ_H;
constexpr size_t W_PC = W_PB + SZ_H;
constexpr size_t W_PH = W_PC + SZ_H;
constexpr size_t W_PZC = W_PH + SZ_H;
constexpr size_t W_PGA = W_PZC + SZ_H;
constexpr size_t W_PGC = W_PGA + SZ_X;
constexpr size_t W_BAR = W_PGC + SZ_X;
constexpr size_t W_CTL = W_BAR + 16384;
constexpr size_t W_G1 = W_CTL + 32768;
constexpr size_t W_END = W_G1 + SZ_H;
constexpr size_t W_YAC = W_WINT;
constexpr size_t W_MG = W_PB;

struct Params {
    const float *x_prompt, *x_sample, *st_re, *st_im, *st_conv, *w_in, *a_re, *a_im, *log_dt, *b_re, *b_im, *c_re, *c_im, *ssm_d, *w_glu, *w_out_a, *conv_w, *w_out_c, *w_o, *ln_g, *ln_b;
    float* out;
    unsigned char* ws;
};

typedef __bf16 bf16v2 __attribute__((ext_vector_type(2)));
typedef float f32v2 __attribute__((ext_vector_type(2)));
__device__ __forceinline__ unsigned cvt_pk_bf16(float lo, float hi) { const f32v2 v = {lo, hi}; const bf16v2 b = __builtin_convertvector(v, bf16v2); return __builtin_bit_cast(unsigned, b); }
__device__ __forceinline__ int tid_opaque() { int t = threadIdx.x; asm volatile("" : "+v"(t)); return t; }
__device__ __forceinline__ float bf_lo(unsigned w) { return __uint_as_float(w << 16); }
__device__ __forceinline__ float bf_hi(unsigned w) { return __uint_as_float(w & 0xffff0000u); }
__device__ __forceinline__ bf16_t f2bf(float f) { return (bf16_t)(cvt_pk_bf16(f, 0.f) & 0xffffu); }
__device__ __forceinline__ float sigmoidf_(float x) { return __builtin_amdgcn_rcpf(1.0f + __expf(-x)); }
__device__ __forceinline__ float siluf_(float x) { return x * sigmoidf_(x); }
__device__ __forceinline__ float gelu_tanh(float y) { const float z = 0.7978845608028654f * (y + 0.044715f * y * y * y); return y * sigmoidf_(2.0f * z); }

#define XB_TMO      128
#define XB_XCNT(j)  (256  + 64 * (j))
#define XB_XSUB(j)  (1280 + 64 * (j))
#define XB_XGEN(j)  (2304 + 64 * (j))
#define XB_TOP      3328
#define XB_TOPGEN   3392
#define XCD_BAR_WORDS 3456
#define XB_SPIN_CAP (1u << 18)
__device__ __forceinline__ unsigned xb_ld(unsigned* p)              { return __hip_atomic_load(p, __ATOMIC_RELAXED, __HIP_MEMORY_SCOPE_AGENT); }
__device__ __forceinline__ unsigned xb_add(unsigned* p, unsigned v) { return __hip_atomic_fetch_add(p, v, __ATOMIC_RELAXED, __HIP_MEMORY_SCOPE_AGENT); }
__device__ __forceinline__ unsigned xb_xcc_id() { return (unsigned)__builtin_amdgcn_s_getreg((3 << 11) | 20) & 0xFu; }
#define XB_SPIN(cond, bar) do { unsigned _sp = 0; while (cond) { __builtin_amdgcn_s_sleep(1); \
    if ((++_sp & 255u) == 0u) { if (xb_ld(&(bar)[XB_TMO])) break; if (_sp > XB_SPIN_CAP) { atomicAdd(&(bar)[XB_TMO], 1u); break; } } } } while (0)

struct XcdBarrier {
    unsigned* bar; unsigned x;
    volatile LAS unsigned* st;
};

__device__ __forceinline__ XcdBarrier xcd_barrier_post(unsigned* bar, volatile LAS unsigned* st) {
    XcdBarrier b; b.bar = bar; b.x = xb_xcc_id(); b.st = st;
    if (threadIdx.x == 0) (void)xb_add(&bar[XB_XCNT(b.x)], 1u);
    return b;
}
__device__ __forceinline__ void xcd_barrier_complete(unsigned* bar, unsigned x, unsigned& nloc, unsigned& nx) {
    const unsigned G = gridDim.x * gridDim.y * gridDim.z;
    unsigned sum, cnt, mine, sp = 0u;
    for (;;) {
        sum = 0u; cnt = 0u; mine = 0u;
#pragma unroll
        for (unsigned j = 0; j < 16; ++j) { const unsigned c = xb_ld(&bar[XB_XCNT(j)]); sum += c; cnt += (c > 0u) ? 1u : 0u; mine = (j == x) ? c : mine; }
        if (sum == G) break;
        __builtin_amdgcn_s_sleep(1);
        if ((++sp & 255u) == 0u) { if (xb_ld(&bar[XB_TMO])) break; if (sp > XB_SPIN_CAP) { atomicAdd(&bar[XB_TMO], 1u); break; } }
    }
    nloc = mine > 0u ? mine : 1u; nx = cnt > 0u ? cnt : 1u;
}

__device__ __forceinline__ void xcd_barrier(const XcdBarrier& b) {
    asm volatile("s_waitcnt vmcnt(0)" ::: "memory");
    __syncthreads();
    if (threadIdx.x == 0) {
        unsigned* bar = b.bar;
        __builtin_amdgcn_s_waitcnt(0);
        unsigned nloc = b.st[0], nx = b.st[1];
        if (nloc == 0u) { xcd_barrier_complete(bar, b.x, nloc, nx); b.st[0] = nloc; b.st[1] = nx; }
        const unsigned old = xb_add(&bar[XB_XSUB(b.x)], 1u);
        const unsigned gen = old / nloc;
        if (old + 1u == (gen + 1u) * nloc) {
            __builtin_amdgcn_fence(__ATOMIC_RELEASE, "agent");
            asm volatile("s_waitcnt vmcnt(0)" ::: "memory");
            const unsigned og = xb_add(&bar[XB_TOP], 1u);
            const unsigned tg = og / nx;
            if (og + 1u == (tg + 1u) * nx) xb_add(&bar[XB_TOPGEN], 1u);
            else XB_SPIN(xb_ld(&bar[XB_TOPGEN]) == tg, bar);
            __builtin_amdgcn_fence(__ATOMIC_ACQUIRE, "agent");
            xb_add(&bar[XB_XGEN(b.x)], 1u);
            asm volatile("s_waitcnt vmcnt(0)" ::: "memory");
        } else {
            XB_SPIN(xb_ld(&bar[XB_XGEN(b.x)]) == gen, bar);
            __builtin_amdgcn_fence(__ATOMIC_ACQUIRE, "agent");
            asm volatile("s_waitcnt vmcnt(0)" ::: "memory");
        }
    }
    __syncthreads();
}

namespace pg8 {
constexpr int BM = 256, BK = 64, HALF = 128, HTB = HALF * BK * 2, STAGE_BYTES = 8 * HTB, NXCD = 8, WGM = 8;
__host__ __device__ __forceinline__ int lds_byte(int r, int c) { const int st = (r >> 4) * 2 + (c >> 5), rr = r & 15, cc = c & 31, ob = rr * 64 + cc * 2; return st * 1024 + (ob ^ (((ob >> 9) & 1) << 5)); }
__host__ __device__ __forceinline__ void stage_rc(int b, int& R, int& C) { const int st = b / 1024, sb = b % 1024, swz = sb ^ (((sb >> 9) & 1) << 5); R = (st >> 1) * 16 + swz / 64; C = (st & 1) * 32 + (swz % 64) / 2; }
__host__ __device__ __forceinline__ int perm32(int rho) { const int n = rho >> 4, i = rho & 15; return 8 * (i >> 2) + 4 * n + (i & 3); }
struct Unit { int pm, pn; };
struct Gemm { const bf16_t* A; const bf16_t* Bt; int K; };

__device__ __forceinline__ void tile_of(int L, int nM, int nN, Unit& u) {
    const int nwg = nM * nN; int wgid = L;
    { const int q = nwg / NXCD, r = nwg % NXCD, xcd = wgid % NXCD, off = wgid / NXCD; wgid = (xcd < r ? xcd * (q + 1) : r * (q + 1) + (xcd - r) * q) + off; }
    const int nig = WGM * nN, gid = wgid / nig, fm = gid * WGM, gsz = (nM - fm) < WGM ? (nM - fm) : WGM;
    u.pm = fm + ((wgid % nig) % gsz); u.pn = (wgid % nig) / gsz;
}
struct StaticOrder {
    int nM, nN, nwg, G, c;
    __device__ void init(int nM_, int nN_, int G_, int c_) { nM = nM_; nN = nN_; nwg = nM * nN; G = G_; c = c_; }
    __device__ __forceinline__ bool next(int i, Unit& u) const { const int L = i * G + c; if (L >= nwg) return false; tile_of(L, nM, nN, u); return true; }
};
struct PairOrder {
    int nM, nN, nwg, G, c;
    __device__ void init(int nM_, int nN_, int G_, int c_) { nM = nM_; nN = nN_; nwg = nM * nN; G = G_; c = c_; }
    __device__ __forceinline__ bool next(int i, Unit& u) const { const int L = (i >> 1) * G + c; if (L >= nwg) return false; tile_of(L, nM, nN, u); if (i & 1) { u.pm += nM; u.pn += nN; } return true; }
};

template <class Epi, class Sched>
__device__ __forceinline__ void gemm_phase(LAS unsigned char* lds, const Gemm g, const Sched& S, const Epi& E) {
    const int tid = tid_opaque(), wid = __builtin_amdgcn_readfirstlane(tid >> 6), lane = tid & 63, wr = wid >> 2, wc = wid & 3, fr = lane & 15, fq = lane >> 4;
    const int K = g.K, nt = K / BK;
    unsigned voffA[2], voffB[2];
#pragma unroll
    for (int i = 0; i < 2; ++i) { int R, C; stage_rc(tid * 16 + i * 8192, R, C); const int Rb = (R & ~31) + perm32(R & 31);
        voffA[i] = (unsigned)(R * K + C) * 2u; voffB[i] = (unsigned)(Rb * K + C) * 2u; }
    const size_t kstep = (size_t)(BK * 2);
    const size_t hstep = (size_t)HALF * K * 2;
    const size_t tstep = 2 * hstep;
    const unsigned ldsw = (unsigned)wid * 1024u;
    const int aoff = lds_byte(wr * 64 + fr, fq * 8), boff = lds_byte(wc * 32 + fr, fq * 8);
#define PG8_SA(b, h) (((b) * 2 + (h)) * HTB)
#define PG8_SB(b, h) ((4 + (b) * 2 + (h)) * HTB)
#define PG8_STAGE(bufoff, gbase, voff) do { _Pragma("unroll") for (int _i = 0; _i < 2; ++_i) \
        __builtin_amdgcn_global_load_lds((const unsigned*)((const char*)(gbase) + (voff)[_i]), (LAS unsigned*)(lds + (bufoff) + ldsw + _i * 8192), 16, 0, 0); } while (0)
#define PG8_LDA(dst, b, h) do { _Pragma("unroll") for (int m = 0; m < 4; ++m) _Pragma("unroll") for (int k = 0; k < 2; ++k) dst[m][k] = *(const LAS bf16x8*)(lds + PG8_SA(b, h) + aoff + m * 2048 + k * 1024); } while (0)
#define PG8_LDB(dst, b, h) do { _Pragma("unroll") for (int n = 0; n < 2; ++n) _Pragma("unroll") for (int k = 0; k < 2; ++k) dst[n][k] = *(const LAS bf16x8*)(lds + PG8_SB(b, h) + boff + n * 2048 + k * 1024); } while (0)
#define PG8_MMA(ai, bj, At, Bt) do { __builtin_amdgcn_s_setprio(1); _Pragma("unroll") for (int m = 0; m < 4; ++m) _Pragma("unroll") for (int n = 0; n < 2; ++n) _Pragma("unroll") for (int k = 0; k < 2; ++k) \
        acc[ai][bj][m][n] = __builtin_amdgcn_mfma_f32_16x16x32_bf16(Bt[n][k], At[m][k], acc[ai][bj][m][n], 0, 0, 0); __builtin_amdgcn_s_setprio(0); } while (0)
#define PG8_WAIT_V(n) asm volatile("s_waitcnt vmcnt(" #n ")" ::: "memory")
#define PG8_WAIT_L(n) asm volatile("s_waitcnt lgkmcnt(" #n ")" ::: "memory")
#define PG8_BAR __builtin_amdgcn_s_barrier()
#define PG8_SCHED __builtin_amdgcn_sched_barrier(0)
    Unit cur, nxt; int ui = 0;
    if (!S.next(0, cur)) return;
    f32x4 acc[2][2][4][2];
#pragma unroll
    for (int a = 0; a < 2; ++a)
#pragma unroll
        for (int b = 0; b < 2; ++b)
#pragma unroll
            for (int m = 0; m < 4; ++m)
#pragma unroll
                for (int n = 0; n < 2; ++n) acc[a][b][m][n] = (f32x4){0.f, 0.f, 0.f, 0.f};
    bf16x8 At[4][2], B0[2][2], B1[2][2];
    const char* cA = (const char*)g.A + (size_t)cur.pm * tstep; const char* cB = (const char*)g.Bt + (size_t)cur.pn * tstep;
    PG8_STAGE(PG8_SB(0, 0), cB, voffB); PG8_STAGE(PG8_SA(0, 0), cA, voffA); PG8_STAGE(PG8_SB(0, 1), cB + hstep, voffB); PG8_STAGE(PG8_SA(0, 1), cA + hstep, voffA);
    if (wr == 1) PG8_BAR;
    PG8_WAIT_V(4); PG8_BAR;
    PG8_STAGE(PG8_SB(1, 0), cB + kstep, voffB); PG8_STAGE(PG8_SA(1, 0), cA + kstep, voffA); PG8_STAGE(PG8_SB(1, 1), cB + hstep + kstep, voffB);
    PG8_WAIT_V(6); PG8_BAR;
    for (;;) {
        const bool has_next = S.next(ui + 1, nxt);
        const char* nA = has_next ? (const char*)g.A + (size_t)nxt.pm * tstep : cA; const char* nB = has_next ? (const char*)g.Bt + (size_t)nxt.pn * tstep : cB;
        for (int t = 0; t < nt; t += 2) {
            const bool last = (t == nt - 2);
            const char* a1 = cA + (size_t)(t + 1) * kstep;
            const char* a2 = last ? nA : cA + (size_t)(t + 2) * kstep; const char* b2 = last ? nB : cB + (size_t)(t + 2) * kstep;
            const char* a3 = a2 + kstep; const char* b3 = b2 + kstep;
            PG8_LDB(B0, 0, 0); PG8_SCHED; PG8_LDA(At, 0, 0); PG8_STAGE(PG8_SA(1, 1), a1 + hstep, voffA);
            PG8_WAIT_L(8); PG8_BAR; PG8_WAIT_L(0); PG8_MMA(0, 0, At, B0); PG8_BAR; PG8_SCHED;
            PG8_LDB(B1, 0, 1); PG8_STAGE(PG8_SB(0, 0), b2, voffB);
            PG8_BAR; PG8_WAIT_L(0); PG8_MMA(0, 1, At, B1); PG8_BAR;
            PG8_LDA(At, 0, 1); PG8_STAGE(PG8_SA(0, 0), a2, voffA);
            PG8_BAR; PG8_WAIT_L(0); PG8_MMA(1, 0, At, B0); PG8_BAR; PG8_SCHED;
            PG8_STAGE(PG8_SB(0, 1), b2 + hstep, voffB);
            PG8_WAIT_V(6); PG8_BAR; PG8_MMA(1, 1, At, B1); PG8_BAR;
            PG8_LDB(B0, 1, 0); PG8_SCHED; PG8_LDA(At, 1, 0); PG8_STAGE(PG8_SA(0, 1), a2 + hstep, voffA);
            PG8_WAIT_L(8); PG8_BAR; PG8_WAIT_L(0); PG8_MMA(0, 0, At, B0); PG8_BAR; PG8_SCHED;
            PG8_LDB(B1, 1, 1); PG8_STAGE(PG8_SB(1, 0), b3, voffB);
            PG8_BAR; PG8_WAIT_L(0); PG8_MMA(0, 1, At, B1); PG8_BAR;
            PG8_LDA(At, 1, 1); PG8_STAGE(PG8_SA(1, 0), a3, voffA);
            PG8_BAR; PG8_WAIT_L(0); PG8_MMA(1, 0, At, B0); PG8_BAR; PG8_SCHED;
            PG8_STAGE(PG8_SB(1, 1), b3 + hstep, voffB);
            PG8_WAIT_V(6); PG8_BAR; PG8_MMA(1, 1, At, B1); PG8_BAR;
        }
        E(acc, cur, wr, wc, fr, fq);
        if (!has_next) break;
#pragma unroll
        for (int a = 0; a < 2; ++a)
#pragma unroll
            for (int b = 0; b < 2; ++b)
#pragma unroll
                for (int m = 0; m < 4; ++m)
#pragma unroll
                    for (int n = 0; n < 2; ++n) acc[a][b][m][n] = (f32x4){0.f, 0.f, 0.f, 0.f};
        cur = nxt; cA = nA; cB = nB; ++ui;
    }
    PG8_WAIT_V(0);
    if (wr == 0) PG8_BAR;
    PG8_BAR;
#undef PG8_SA
#undef PG8_SB
#undef PG8_STAGE
#undef PG8_LDA
#undef PG8_LDB
#undef PG8_MMA
#undef PG8_WAIT_V
#undef PG8_WAIT_L
#undef PG8_BAR
#undef PG8_SCHED
}
}

#define EPI_LOOP_BEGIN \
    _Pragma("unroll") for (int ai = 0; ai < 2; ++ai) _Pragma("unroll") for (int m = 0; m < 4; ++m) _Pragma("unroll") for (int bj = 0; bj < 2; ++bj) { \
        const int rl = ai * 128 + wr * 64 + m * 16 + fr, cl = bj * 128 + wc * 32 + 8 * fq; const f32x4 v0 = acc[ai][bj][m][0], v1 = acc[ai][bj][m][1];
#define EPI_LOOP_END }

__device__ __forceinline__ u32x4 pack8(const f32x4 a, const f32x4 b) { u32x4 o; o[0] = cvt_pk_bf16(a[0], a[1]); o[1] = cvt_pk_bf16(a[2], a[3]); o[2] = cvt_pk_bf16(b[0], b[1]); o[3] = cvt_pk_bf16(b[2], b[3]); return o; }

struct EpiProj {
    unsigned char* ws;
    __device__ __forceinline__ void operator()(const f32x4 (&acc)[2][2][4][2], const pg8::Unit& u, int wr, int wc, int fr, int fq) const {
        const int pn = u.pn, row0 = u.pm * 256;
        if (pn < 4) {
            bf16_t* PU = (bf16_t*)(ws + W_PU);
            EPI_LOOP_BEGIN
                const int ch = pn * 256 + cl, g = ch >> 4, half = (ch >> 3) & 1;
                *(u32x4*)(PU + ((size_t)g * MT + row0 + rl) * 16 + half * 8) = pack8(v0, v1);
            EPI_LOOP_END
            return;
        }
        if (pn >= 8 && pn < 24) {
            bf16_t* dst = (bf16_t*)(ws + (wc < 2 ? W_PC : W_PB)) + (pn - 8) * 64 + (wc & 1) * 32 + 8 * fq;
#pragma unroll
            for (int ai = 0; ai < 2; ++ai)
#pragma unroll
                for (int m = 0; m < 4; ++m) {
                    const int rl = ai * 128 + wr * 64 + m * 16 + fr;
                    f32x4 a = acc[ai][0][m][0], b = acc[ai][0][m][1]; const f32x4 a2 = acc[ai][1][m][0], b2 = acc[ai][1][m][1];
                    if (wc < 2) { a = a * a2; b = b * b2; }
                    else { _Pragma("unroll") for (int j = 0; j < 4; ++j) { a[j] *= siluf_(a2[j]); b[j] *= siluf_(b2[j]); } }
                    *(u32x4*)(dst + (size_t)(row0 + rl) * 1024) = pack8(a, b);
                }
            return;
        }
        bf16_t* base; int ld, colt, act;
        if (pn < 8) { colt = (pn & 3) * 256; ld = 1024; act = 1; base = (bf16_t*)(ws + W_PZA); }
        else {
            bf16_t* SA = (bf16_t*)(ws + W_PGA) + (pn - 24) * 128 + wc * 32 + 8 * fq; bf16_t* RT = (bf16_t*)(ws + W_PGC) + (pn - 24) * 128 + wc * 32 + 8 * fq;
#pragma unroll
            for (int ai = 0; ai < 2; ++ai)
#pragma unroll
                for (int m = 0; m < 4; ++m) {
                    const int rl = ai * 128 + wr * 64 + m * 16 + fr;
                    f32x4 s0, s1, r0, r1;
#pragma unroll
                    for (int j = 0; j < 4; ++j) {
                        const float ea0 = fminf(__expf(-acc[ai][0][m][0][j]), 1e30f), ec0 = __expf(-acc[ai][1][m][0][j]), ea1 = fminf(__expf(-acc[ai][0][m][1][j]), 1e30f), ec1 = __expf(-acc[ai][1][m][1][j]);
                        s0[j] = __builtin_amdgcn_rcpf(1.0f + ea0); r0[j] = (1.0f + ea0) * __builtin_amdgcn_rcpf(1.0f + ec0);
                        s1[j] = __builtin_amdgcn_rcpf(1.0f + ea1); r1[j] = (1.0f + ea1) * __builtin_amdgcn_rcpf(1.0f + ec1); }
                    *(u32x4*)(SA + (size_t)(row0 + rl) * 2048) = pack8(s0, s1); *(u32x4*)(RT + (size_t)(row0 + rl) * 2048) = pack8(r0, r1);
                }
            return;
        }
        EPI_LOOP_BEGIN
            f32x4 a = v0, b = v1;
            if (act == 1) { _Pragma("unroll") for (int j = 0; j < 4; ++j) { a[j] = siluf_(a[j]); b[j] = siluf_(b[j]); } }
            else if (act == 2) { _Pragma("unroll") for (int j = 0; j < 4; ++j) { a[j] = sigmoidf_(a[j]); b[j] = sigmoidf_(b[j]); } }
            *(u32x4*)(base + (size_t)(row0 + rl) * ld + colt + cl) = pack8(a, b);
        EPI_LOOP_END
    }
};
#define EPI_HALF_BEGIN _Pragma("unroll") for (int ai = 0; ai < 2; ++ai) {
#define EPI_HALF_END }
#define EPI_MB_LOOP _Pragma("unroll") for (int m = 0; m < 4; ++m) _Pragma("unroll") for (int bj = 0; bj < 2; ++bj)
#define EPI_RL (ai * 128 + wr * 64 + m * 16 + fr)
#define EPI_CL (bj * 128 + wc * 32 + 8 * fq)
struct EpiGlu {
    unsigned char* ws;
    __device__ __forceinline__ void operator()(const f32x4 (&acc)[2][2][4][2], const pg8::Unit& u, int wr, int wc, int fr, int fq) const {
        const bf16_t* G1 = (const bf16_t*)(ws + W_G1); const bf16_t* ZA = (const bf16_t*)(ws + W_PZA); bf16_t* YA = (bf16_t*)(ws + W_YAC);
        EPI_HALF_BEGIN
            u32x4 gv[4][2], zv[4][2];
            EPI_MB_LOOP { const size_t o = (size_t)(u.pm * 256 + EPI_RL) * 1024 + u.pn * 256 + EPI_CL; gv[m][bj] = *(const u32x4*)(G1 + o); zv[m][bj] = *(const u32x4*)(ZA + o); }
            EPI_MB_LOOP { const size_t o = (size_t)(u.pm * 256 + EPI_RL) * 1024 + u.pn * 256 + EPI_CL;
                const f32x4 v0 = acc[ai][bj][m][0], v1 = acc[ai][bj][m][1]; const u32x4 g = gv[m][bj], z = zv[m][bj];
                f32x4 a, b;
                a[0] = bf_lo(g[0]) * sigmoidf_(v0[0]) * bf_lo(z[0]); a[1] = bf_hi(g[0]) * sigmoidf_(v0[1]) * bf_hi(z[0]);
                a[2] = bf_lo(g[1]) * sigmoidf_(v0[2]) * bf_lo(z[1]); a[3] = bf_hi(g[1]) * sigmoidf_(v0[3]) * bf_hi(z[1]);
                b[0] = bf_lo(g[2]) * sigmoidf_(v1[0]) * bf_lo(z[2]); b[1] = bf_hi(g[2]) * sigmoidf_(v1[1]) * bf_hi(z[2]);
                b[2] = bf_lo(g[3]) * sigmoidf_(v1[2]) * bf_lo(z[3]); b[3] = bf_hi(g[3]) * sigmoidf_(v1[3]) * bf_hi(z[3]);
                *(u32x4*)(YA + o) = pack8(a, b); }
        EPI_HALF_END
    }
};
struct EpiMerge {
    unsigned char* ws;
    __device__ __forceinline__ void operator()(const f32x4 (&acc)[2][2][4][2], const pg8::Unit& u, int wr, int wc, int fr, int fq) const {
        const bool second = u.pm >= 36; const int pm = second ? u.pm - 36 : u.pm, pn = second ? u.pn - 8 : u.pn;
        const bf16_t* GT = (const bf16_t*)(ws + (second ? W_PGC : W_PGA)); bf16_t* MG = (bf16_t*)(ws + W_MG);
        EPI_HALF_BEGIN
            u32x4 gv[4][2], pv[4][2];
            EPI_MB_LOOP { const size_t o = (size_t)(pm * 256 + EPI_RL) * 2048 + pn * 256 + EPI_CL; gv[m][bj] = *(const u32x4*)(GT + o); }
            if (second) { EPI_MB_LOOP { const size_t o = (size_t)(pm * 256 + EPI_RL) * 2048 + pn * 256 + EPI_CL; pv[m][bj] = *(const u32x4*)(MG + o); } }
            else { EPI_MB_LOOP pv[m][bj] = (u32x4){0u, 0u, 0u, 0u}; }
            EPI_MB_LOOP { const size_t o = (size_t)(pm * 256 + EPI_RL) * 2048 + pn * 256 + EPI_CL;
                const f32x4 v0 = acc[ai][bj][m][0], v1 = acc[ai][bj][m][1]; const u32x4 g = gv[m][bj], q = pv[m][bj];
                f32x4 a, b;
                a[0] = bf_lo(g[0]) * v0[0] + bf_lo(q[0]); a[1] = bf_hi(g[0]) * v0[1] + bf_hi(q[0]); a[2] = bf_lo(g[1]) * v0[2] + bf_lo(q[1]); a[3] = bf_hi(g[1]) * v0[3] + bf_hi(q[1]);
                b[0] = bf_lo(g[2]) * v1[0] + bf_lo(q[2]); b[1] = bf_hi(g[2]) * v1[1] + bf_hi(q[2]); b[2] = bf_lo(g[3]) * v1[2] + bf_lo(q[3]); b[3] = bf_hi(g[3]) * v1[3] + bf_hi(q[3]);
                *(u32x4*)(MG + o) = pack8(a, b); }
        EPI_HALF_END
    }
};
struct EpiResid {
    const float* xp; const float* xs; float* out;
    __device__ __forceinline__ void operator()(const f32x4 (&acc)[2][2][4][2], const pg8::Unit& u, int wr, int wc, int fr, int fq) const {
        EPI_HALF_BEGIN
            f32x4 x0[4][2], x1[4][2];
            EPI_MB_LOOP { const int row = u.pm * 256 + EPI_RL, col = u.pn * 256 + EPI_CL;
                const float* xr = row < MP ? xp + (size_t)row * D_MODEL : xs + (size_t)(row - MP) * D_MODEL;
                x0[m][bj] = *(const f32x4*)(xr + col); x1[m][bj] = *(const f32x4*)(xr + col + 4); }
            EPI_MB_LOOP { const int row = u.pm * 256 + EPI_RL, col = u.pn * 256 + EPI_CL;
                float* o = out + (size_t)row * D_MODEL + col;
                *(f32x4*)o = x0[m][bj] * DN_ALPHA + acc[ai][bj][m][0]; *(f32x4*)(o + 4) = x1[m][bj] * DN_ALPHA + acc[ai][bj][m][1]; }
        EPI_HALF_END
    }
};

__device__ __forceinline__ void transpose_tile(const float* __restrict__ W, int K, int N, bf16_t* __restrict__ Wt, int kt, int ntile, LAS float* tile, int ldt, int kd0, int nd0) {
    const int t = tid_opaque(), k0 = kt * 64, n0 = ntile * 64;
    const int r = t >> 4, c4 = (t & 15) * 4;
#pragma unroll
    for (int h = 0; h < 2; ++h) { const f32x4 v = __builtin_nontemporal_load((const f32x4*)(W + (size_t)(k0 + r + 32 * h) * N + n0 + c4));
#pragma unroll
        for (int j = 0; j < 4; ++j) tile[(r + 32 * h) * 65 + c4 + j] = v[j]; }
    __syncthreads();
    const int n = t >> 3, k8 = (t & 7) * 8;
    float v[8];
#pragma unroll
    for (int j = 0; j < 8; ++j) v[j] = tile[(k8 + j) * 65 + n];
    u32x4 o; o[0] = cvt_pk_bf16(v[0], v[1]); o[1] = cvt_pk_bf16(v[2], v[3]); o[2] = cvt_pk_bf16(v[4], v[5]); o[3] = cvt_pk_bf16(v[6], v[7]);
    *(u32x4*)(Wt + (size_t)(nd0 + n) * ldt + kd0 + k8) = o;
    __syncthreads();
}
__device__ __forceinline__ void phase_convert(const Params& p, LAS unsigned char* lds) {
    const int G = gridDim.x, bid = blockIdx.x, tid = tid_opaque();
    {
        bf16_t* XB = (bf16_t*)(p.ws + W_XB);
        const size_t nitems = (size_t)MT * D_MODEL / 8, np = (size_t)MP * D_MODEL / 8;
        for (size_t i = (size_t)bid * 512 + tid; i < nitems; i += (size_t)G * 512) {
            const float* src = i < np ? p.x_prompt + i * 8 : p.x_sample + (i - np) * 8;
            const f32x4 a = __builtin_nontemporal_load((const f32x4*)src), b = __builtin_nontemporal_load((const f32x4*)(src + 4));
            *(u32x4*)(XB + i * 8) = pack8(a, b);
        }
    }
    LAS float* tile = (LAS float*)lds;
    {
        const float* W = p.w_in; bf16_t* Wt = (bf16_t*)(p.ws + W_WINT);
        const int r = tid >> 4, c4 = (tid & 15) * 4, n = tid >> 3, k8 = (tid & 7) * 8;
        f32x4 a0 = {0.f, 0.f, 0.f, 0.f}, a1 = a0, b0 = a0, b1 = a0;
        int j = bid;
        if (j < 5120) { const int k0 = (j / 160) * 64, n0 = (j % 160) * 64; a0 = __builtin_nontemporal_load((const f32x4*)(W + (size_t)(k0 + r) * NIN + n0 + c4)); a1 = __builtin_nontemporal_load((const f32x4*)(W + (size_t)(k0 + r + 32) * NIN + n0 + c4)); }
        if (j + G < 5120) { const int jj = j + G, k0 = (jj / 160) * 64, n0 = (jj % 160) * 64; b0 = __builtin_nontemporal_load((const f32x4*)(W + (size_t)(k0 + r) * NIN + n0 + c4)); b1 = __builtin_nontemporal_load((const f32x4*)(W + (size_t)(k0 + r + 32) * NIN + n0 + c4)); }
        while (j < 5120) {
            f32x4 c0 = a0, c1 = a1;
            if (j + 2 * G < 5120) { const int jj = j + 2 * G, k0 = (jj / 160) * 64, n0 = (jj % 160) * 64; c0 = __builtin_nontemporal_load((const f32x4*)(W + (size_t)(k0 + r) * NIN + n0 + c4)); c1 = __builtin_nontemporal_load((const f32x4*)(W + (size_t)(k0 + r + 32) * NIN + n0 + c4)); }
#pragma unroll
            for (int q = 0; q < 4; ++q) { tile[r * 65 + c4 + q] = a0[q]; tile[(r + 32) * 65 + c4 + q] = a1[q]; }
            asm volatile("s_waitcnt lgkmcnt(0)" ::: "memory"); __builtin_amdgcn_s_barrier(); asm volatile("" ::: "memory");
            float v[8];
#pragma unroll
            for (int q = 0; q < 8; ++q) v[q] = tile[(k8 + q) * 65 + n];
            u32x4 o; o[0] = cvt_pk_bf16(v[0], v[1]); o[1] = cvt_pk_bf16(v[2], v[3]); o[2] = cvt_pk_bf16(v[4], v[5]); o[3] = cvt_pk_bf16(v[6], v[7]);
            const int n0 = (j % 160) * 64; int nd0 = n0;
            if (n0 >= 6144) { const int kind = (n0 - 6144) >> 11, cc = (n0 - 6144) & 2047; nd0 = 6144 + (cc >> 7) * 256 + kind * 128 + ((cc >> 6) & 1) * 64; }
            else if (n0 >= 2048) { const int kind = (n0 - 2048) >> 10, t64 = ((n0 - 2048) & 1023) >> 6, slot = kind == 0 ? 1 : kind == 1 ? 0 : kind; nd0 = 2048 + t64 * 256 + slot * 64; }
            *(u32x4*)(Wt + (size_t)(nd0 + n) * 2048 + (j / 160) * 64 + k8) = o;
            asm volatile("s_waitcnt lgkmcnt(0)" ::: "memory"); __builtin_amdgcn_s_barrier(); asm volatile("" ::: "memory");
            j += G; a0 = b0; a1 = b1; b0 = c0; b1 = c1;
        }
    }
}
__device__ __forceinline__ void phase_convert_late(const Params& p, LAS unsigned char* lds, int bidx, int nblk) {
    LAS float* tile = (LAS float*)lds;
    for (int j = bidx; j < 2304; j += nblk) {
        const float* W; bf16_t* Wt; int K, N, jj;
        if (j < 512) { W = p.w_out_a; Wt = (bf16_t*)(p.ws + W_WOACT); K = 1024; N = 2048; jj = j; }
        else if (j < 1024) { W = p.w_out_c; Wt = (bf16_t*)(p.ws + W_WOACT) + (size_t)2048 * 1024; K = 1024; N = 2048; jj = j - 512; }
        else if (j < 2048) { W = p.w_o; Wt = (bf16_t*)(p.ws + W_WOT); K = 2048; N = 2048; jj = j - 1024; }
        else { W = p.w_glu; Wt = (bf16_t*)(p.ws + W_WGLUT); K = 1024; N = 1024; jj = j - 2048; }
        const int nn = N / 64, kt = jj / nn; int kd0 = kt * 64;
        if (K == 2048 && kd0 >= 1024) { kd0 -= 1024; Wt += (size_t)2048 * 1024; }
        transpose_tile(W, K, N, Wt, kt, jj % nn, tile, 1024, kd0, (jj % nn) * 64);
    }
}

constexpr int L_LAM = 0, L_E = 4608, L_WT = L_E + 4096, L_VT = L_WT + 128 * 272, L_KM = L_VT + 144 * 272, L_U = L_KM + 4096, L_HIN = L_U + 64 * 272, L_S = L_HIN + 64 * 272, L_SSM_END = L_S + 32768;
constexpr int L_BBT = L_U;
constexpr int LDS_BYTES = 155648;
static_assert(L_SSM_END <= LDS_BYTES - 32, "lds");
static_assert(pg8::STAGE_BYTES <= LDS_BYTES - 32, "lds");

__device__ __forceinline__ void ssm_setup(const Params& p, int g, LAS unsigned char* lds, int w, int fr, int fq) {
    const int tid = tid_opaque();
    LAS float* lam = (LAS float*)(lds + L_LAM);
    LAS float* bbar = (LAS float*)(lds + L_S);
    LAS float* ct = (LAS float*)(lds + L_S + 8192);
    LAS float* qv = (LAS float*)(lds + L_S + 16384);
    __syncthreads();
    {
        const float dt = expf(p.log_dt[g]);
        for (int e = tid; e < 576; e += 512) { const int k = e >> 6, pp = e & 63; const float ar = p.a_re[g * 64 + pp], ai = p.a_im[g * 64 + pp];
            const float mg = expf((float)k * (ar * dt)), a = (float)k * (ai * dt); lam[e * 2] = mg * cosf(a); lam[e * 2 + 1] = mg * sinf(a); }
        if (tid < 64) { const float ar = p.a_re[g * 64 + tid], ai = p.a_im[g * 64 + tid], ang = ai * dt, x = ar * dt;
            const float em1 = expm1f(x), mg = em1 + 1.0f, sh = sinf(0.5f * ang);
            const float lrm1 = em1 - 2.0f * mg * sh * sh, li = mg * sinf(ang), den = ar * ar + ai * ai;
            qv[tid * 2] = (lrm1 * ar + li * ai) / den; qv[tid * 2 + 1] = (li * ar - lrm1 * ai) / den; }
#pragma unroll
        for (int j = 0; j < 2; ++j) { const int e = tid + 512 * j; ct[e * 2] = p.c_re[(size_t)g * 1024 + e]; ct[e * 2 + 1] = p.c_im[(size_t)g * 1024 + e]; }
    }
    __syncthreads();
#pragma unroll
    for (int j = 0; j < 2; ++j) {
        const int e = tid + 512 * j, pp = e >> 4;
        const float br = p.b_re[(size_t)g * 1024 + e], bi = p.b_im[(size_t)g * 1024 + e], qr = qv[pp * 2], qi = qv[pp * 2 + 1];
        bbar[e * 2] = qr * br - qi * bi; bbar[e * 2 + 1] = qr * bi + qi * br;
    }
    __syncthreads();
#pragma unroll
    for (int j = 0; j < 4; ++j) {
        const int it = tid + 512 * j, n = it >> 4, oct = it & 15, ri = n >> 6, pp = n & 63, s = oct >> 1, c0 = (oct & 1) * 8;
        const float lr = lam[((7 - s) * 64 + pp) * 2], li = lam[((7 - s) * 64 + pp) * 2 + 1];
        float v[8];
#pragma unroll
        for (int q = 0; q < 4; ++q) { const f32x4 bb = *(const LAS f32x4*)(bbar + (pp * 16 + c0 + 2 * q) * 2);
            v[2 * q] = ri == 0 ? lr * bb[0] - li * bb[1] : lr * bb[1] + li * bb[0]; v[2 * q + 1] = ri == 0 ? lr * bb[2] - li * bb[3] : lr * bb[3] + li * bb[2]; }
        u32x4 o; o[0] = cvt_pk_bf16(v[0], v[1]); o[1] = cvt_pk_bf16(v[2], v[3]); o[2] = cvt_pk_bf16(v[4], v[5]); o[3] = cvt_pk_bf16(v[6], v[7]);
        *(LAS u32x4*)(lds + L_WT + n * 272 + oct * 16) = o;
    }
    if (tid < 256) {
        const int c = tid >> 4, oct = tid & 15, ri = oct >> 3, p0 = (oct & 7) * 8;
        float v[8];
#pragma unroll
        for (int q = 0; q < 8; ++q) v[q] = bbar[((p0 + q) * 16 + c) * 2 + ri];
        u32x4 o; o[0] = cvt_pk_bf16(v[0], v[1]); o[1] = cvt_pk_bf16(v[2], v[3]); o[2] = cvt_pk_bf16(v[4], v[5]); o[3] = cvt_pk_bf16(v[6], v[7]);
        *(LAS u32x4*)(lds + L_BBT + c * 272 + oct * 16) = o;
    }
    for (int it = tid; it < 2304; it += 512) {
        const int n = it >> 4, oct = it & 15, k = n >> 4, c = n & 15, ri = oct >> 3, p0 = (oct & 7) * 8;
        float v[8];
#pragma unroll
        for (int q = 0; q < 4; ++q) { const f32x4 ll = *(const LAS f32x4*)(lam + (k * 64 + p0 + 2 * q) * 2), cc = *(const LAS f32x4*)(ct + (c * 64 + p0 + 2 * q) * 2);
            v[2 * q] = ri == 0 ? cc[0] * ll[0] - cc[1] * ll[1] : -(cc[0] * ll[1] + cc[1] * ll[0]); v[2 * q + 1] = ri == 0 ? cc[2] * ll[2] - cc[3] * ll[3] : -(cc[2] * ll[3] + cc[3] * ll[2]); }
        u32x4 o; o[0] = cvt_pk_bf16(v[0], v[1]); o[1] = cvt_pk_bf16(v[2], v[3]); o[2] = cvt_pk_bf16(v[4], v[5]); o[3] = cvt_pk_bf16(v[6], v[7]);
        *(LAS u32x4*)(lds + L_VT + n * 272 + oct * 16) = o;
    }
    __syncthreads();
    {
        f32x4 acc = {0.f, 0.f, 0.f, 0.f};
#pragma unroll
        for (int kk = 0; kk < 4; ++kk) {
            const bf16x8 bq = *(const LAS bf16x8*)(lds + L_BBT + fr * 272 + kk * 64 + fq * 16);
            const bf16x8 av = *(const LAS bf16x8*)(lds + L_VT + (w * 16 + fr) * 272 + kk * 64 + fq * 16);
            acc = __builtin_amdgcn_mfma_f32_16x16x32_bf16(bq, av, acc, 0, 0, 0);
        }
        u32x2 o; o[0] = cvt_pk_bf16(acc[0], acc[1]); o[1] = cvt_pk_bf16(acc[2], acc[3]);
        *(LAS u32x2*)(lds + L_KM + ((w * 16 + fr) * 16 + fq * 4) * 2) = o;
    }
    __syncthreads();
}

__device__ __forceinline__ void ssm_pass_a(LAS unsigned char* lds, int nrb, int w, int fr, int fq) {
    bf16x8 bw[4];
#pragma unroll
    for (int kk = 0; kk < 4; ++kk) bw[kk] = *(const LAS bf16x8*)(lds + L_WT + (w * 16 + fr) * 272 + kk * 64 + fq * 16);
    LAS float* S = (LAS float*)(lds + L_S);
    for (int rb = 0; rb < nrb; ++rb) {
        f32x4 acc = {0.f, 0.f, 0.f, 0.f};
#pragma unroll
        for (int kk = 0; kk < 4; ++kk) { const bf16x8 a = *(const LAS bf16x8*)(lds + L_U + (rb * 16 + fr) * 272 + kk * 64 + fq * 16); acc = __builtin_amdgcn_mfma_f32_16x16x32_bf16(a, bw[kk], acc, 0, 0, 0); }
#pragma unroll
        for (int j = 0; j < 4; ++j) S[(rb * 16 + fq * 4 + j) * 128 + w * 16 + fr] = acc[j];
    }
}
__device__ __forceinline__ void ssm_pass_c(const Params& p, LAS unsigned char* lds, int nrb, int t, int fr, int fq, int g, int tok_base) {
    bf16_t* G1 = (bf16_t*)(p.ws + W_G1);
    const f32x4 dv = *(const f32x4*)(p.ssm_d + g * 16 + fq * 4);
    for (int rb = 0; rb < nrb; ++rb) {
        f32x4 acc = {0.f, 0.f, 0.f, 0.f};
#pragma unroll
        for (int kk = 0; kk < 4; ++kk) {
            const bf16x8 bv = *(const LAS bf16x8*)(lds + L_VT + ((t + 1) * 16 + fr) * 272 + kk * 64 + fq * 16);
            const bf16x8 ah = *(const LAS bf16x8*)(lds + L_HIN + (rb * 16 + fr) * 272 + kk * 64 + fq * 16);
            acc = __builtin_amdgcn_mfma_f32_16x16x32_bf16(bv, ah, acc, 0, 0, 0);
        }
#pragma unroll
        for (int kk = 0; kk < 4; ++kk) {
            if (2 * kk <= t) {
                const int lag = t - 2 * kk - (fq >> 1);
                bf16x8 bk = *(const LAS bf16x8*)(lds + L_KM + (((lag < 0 ? 0 : lag) * 16 + fr) * 16 + (fq & 1) * 8) * 2);
                if (lag < 0) bk = (bf16x8){0, 0, 0, 0, 0, 0, 0, 0};
                const bf16x8 au = *(const LAS bf16x8*)(lds + L_U + (rb * 16 + fr) * 272 + kk * 64 + fq * 16);
                acc = __builtin_amdgcn_mfma_f32_16x16x32_bf16(bk, au, acc, 0, 0, 0);
            }
        }
        const int rr = rb * 16 + fr;
        const u32x2 uv = *(const LAS u32x2*)(lds + L_U + rr * 272 + (t * 16 + fq * 4) * 2);
        f32x4 y;
        y[0] = gelu_tanh(acc[0] + dv[0] * bf_lo(uv[0])); y[1] = gelu_tanh(acc[1] + dv[1] * bf_hi(uv[0]));
        y[2] = gelu_tanh(acc[2] + dv[2] * bf_lo(uv[1])); y[3] = gelu_tanh(acc[3] + dv[3] * bf_hi(uv[1]));
        u32x2 o; o[0] = cvt_pk_bf16(y[0], y[1]); o[1] = cvt_pk_bf16(y[2], y[3]);
        *(u32x2*)(G1 + (size_t)(tok_base + rr * 8 + t) * 1024 + g * 16 + fq * 4) = o;
    }
}

__device__ __forceinline__ void unpack8(const u32x4 v, float (&f)[8]) { f[0] = bf_lo(v[0]); f[1] = bf_hi(v[0]); f[2] = bf_lo(v[1]); f[3] = bf_hi(v[1]); f[4] = bf_lo(v[2]); f[5] = bf_hi(v[2]); f[6] = bf_lo(v[3]); f[7] = bf_hi(v[3]); }
constexpr int CONV_ITEMS = (MT / 8) * 128;
template <int T0, int T1> __device__ __forceinline__ void conv_issue(const Params& p, int i, u32x4 (&qv)[8], u32x4 (&bv)[8]) {
    const bf16_t* BZ = (const bf16_t*)(p.ws + W_PB); const bf16_t* Q = (const bf16_t*)(p.ws + W_PC);
    const int c8 = (i & 127) * 8, row0 = (i >> 7) * 8;
#pragma unroll
    for (int t = T0; t < T1; ++t) { const size_t o = (size_t)(row0 + t) * 1024 + c8; qv[t] = *(const u32x4*)(Q + o); bv[t] = *(const u32x4*)(BZ + o); }
}
__device__ __forceinline__ void conv_finish(const Params& p, int i, const u32x4 (&qv)[8], const u32x4 (&bv)[8]) {
    const bf16_t* Q = (const bf16_t*)(p.ws + W_PC);
    bf16_t* YC = (bf16_t*)(p.ws + W_YAC) + (size_t)MT * 1024;
    const int c8 = (i & 127) * 8, chunk = i >> 7, row0 = chunk * 8;
    float w0[8], w1[8], w2[8], q2[8], q1[8];
#pragma unroll
    for (int j = 0; j < 8; ++j) { w0[j] = p.conv_w[c8 + j]; w1[j] = p.conv_w[1024 + c8 + j]; w2[j] = p.conv_w[2048 + c8 + j]; }
    const bool sample = row0 >= MP; const int t0 = sample ? 0 : (row0 & (SEQ - 1));
    if (sample) { const int b = (row0 - MP) >> 3; const float* sc = p.st_conv + (size_t)b * 2048 + c8;
#pragma unroll
        for (int j = 0; j < 8; ++j) { q2[j] = sc[j]; q1[j] = sc[1024 + j]; } }
    else if (t0 == 0) {
#pragma unroll
        for (int j = 0; j < 8; ++j) { q2[j] = 0.f; q1[j] = 0.f; } }
    else { unpack8(*(const u32x4*)(Q + (size_t)(row0 - 2) * 1024 + c8), q2); unpack8(*(const u32x4*)(Q + (size_t)(row0 - 1) * 1024 + c8), q1); }
#pragma unroll
    for (int t = 0; t < 8; ++t) {
        const size_t o = (size_t)(row0 + t) * 1024 + c8;
        float qq[8], bb[8], y[8];
        unpack8(qv[t], qq); unpack8(bv[t], bb);
#pragma unroll
        for (int j = 0; j < 8; ++j) { const float q = qq[j]; y[j] = bb[j] * (q2[j] * w0[j] + q1[j] * w1[j] + q * w2[j]); q2[j] = q1[j]; q1[j] = q; }
        u32x4 ov; ov[0] = cvt_pk_bf16(y[0], y[1]); ov[1] = cvt_pk_bf16(y[2], y[3]); ov[2] = cvt_pk_bf16(y[4], y[5]); ov[3] = cvt_pk_bf16(y[6], y[7]);
        *(u32x4*)(YC + o) = ov;
    }
    if (sample) { const int b = (row0 - MP) >> 3; float* d = p.out + O_CVS + (size_t)b * 2048 + c8;
#pragma unroll
        for (int j = 0; j < 8; ++j) { d[j] = q2[j]; d[1024 + j] = q1[j]; } }
    else if (t0 == SEQ - 8) { const int b = row0 >> 11; float* d = p.out + O_CVP + (size_t)b * 2048 + c8;
#pragma unroll
        for (int j = 0; j < 8; ++j) { d[j] = q2[j]; d[1024 + j] = q1[j]; } }
}

__device__ __forceinline__ void lds_barrier() { asm volatile("s_waitcnt lgkmcnt(0)" ::: "memory"); __builtin_amdgcn_s_barrier(); asm volatile("" ::: "memory"); }
__device__ __forceinline__ void phase_ssm(const Params& p, LAS unsigned char* lds) {
    const int tid = tid_opaque(), w = __builtin_amdgcn_readfirstlane(tid >> 6), lane = tid & 63, fr = lane & 15, fq = lane >> 4;
    const bf16_t* PU = (const bf16_t*)(p.ws + W_PU);
    LAS float* lam = (LAS float*)(lds + L_LAM);
    LAS float* S = (LAS float*)(lds + L_S);
    LAS float* E = (LAS float*)(lds + L_E);
    int g_cur = -1;
    const int ci = blockIdx.x * 512 + tid; bool cpref = false; u32x4 cq[8], cb[8];
    bool pref = false; u32x4 pua = {0u, 0u, 0u, 0u}, puc = {0u, 0u, 0u, 0u}; float ph0r[4] = {0.f, 0.f, 0.f, 0.f}, ph0i[4] = {0.f, 0.f, 0.f, 0.f};
    for (int unit = blockIdx.x; unit < 512; unit += gridDim.x) {
        const int g = unit & 63, sub = (unit >> 6) & 3; const bool sample = unit >= 256;
        if (g != g_cur) { ssm_setup(p, g, lds, w, fr, fq); g_cur = g; }
        const float l8r = lam[(8 * 64 + lane) * 2], l8i = lam[(8 * 64 + lane) * 2 + 1];
        if (!sample) {
            const int b = sub;
            if (!cpref && ci < CONV_ITEMS) { conv_issue<0, 4>(p, ci, cq, cb); cpref = true; }
            {
                const int nu = unit + gridDim.x; pref = nu >= 256 && nu < 512;
                if (pref) { const int gs = nu & 63, b0s = ((nu >> 6) & 3) * 32;
                    if (tid < 256) { const u32x4* src = (const u32x4*)(PU + ((size_t)gs * MT + MP + b0s * 8 + tid) * 16); pua = src[0]; puc = src[1]; }
#pragma unroll
                    for (int j = 0; j < 4; ++j) { const int e = tid + 512 * j, rr = e >> 6, pp = e & 63; const size_t o = ((size_t)(b0s + rr) * 64 + gs) * 64 + pp; ph0r[j] = p.st_re[o]; ph0i[j] = p.st_im[o]; } }
            }
            float l64r, l64i; { float ar = l8r * l8r - l8i * l8i, ai = 2.f * l8r * l8i; float br = ar * ar - ai * ai, bi = 2.f * ar * ai; l64r = br * br - bi * bi; l64i = 2.f * br * bi; }
            float hsr = 0.f, hsi = 0.f;
            u32x4 ua, uc; { const u32x4* src = (const u32x4*)(PU + ((size_t)g * MT + b * SEQ + tid) * 16); ua = src[0]; uc = src[1]; }

            for (int seg = 0; seg < 4; ++seg) {
                const int tok_base = b * SEQ + seg * 512;
                {
                    LAS unsigned char* d = lds + L_U + (tid >> 3) * 272 + (tid & 7) * 32;
                    *(LAS u32x4*)d = ua; *(LAS u32x4*)(d + 16) = uc;
                    if (seg < 3) { const u32x4* src = (const u32x4*)(PU + ((size_t)g * MT + tok_base + 512 + tid) * 16); ua = src[0]; uc = src[1]; }
                }
                lds_barrier();
                ssm_pass_a(lds, 4, w, fr, fq);
                lds_barrier();
                float xr[8], xi[8];
#pragma unroll
                for (int i = 0; i < 8; ++i) { xr[i] = S[(8 * w + i) * 128 + lane]; xi[i] = S[(8 * w + i) * 128 + 64 + lane]; }
                float hr = 0.f, hi = 0.f;
#pragma unroll
                for (int i = 0; i < 8; ++i) { const float sr = xr[i], si = xi[i]; xr[i] = hr; xi[i] = hi; const float nr = l8r * hr - l8i * hi + sr, ni = l8r * hi + l8i * hr + si; hr = nr; hi = ni; }
                E[w * 128 + lane] = hr; E[w * 128 + 64 + lane] = hi;
                lds_barrier();
                float cr = hsr, ci = hsi, myr = 0.f, myi = 0.f;
#pragma unroll
                for (int jj = 0; jj < 8; ++jj) { if (jj == w) { myr = cr; myi = ci; } const float er = E[jj * 128 + lane], ei = E[jj * 128 + 64 + lane];
                    const float nr = l64r * cr - l64i * ci + er, ni = l64r * ci + l64i * cr + ei; cr = nr; ci = ni; }
                hsr = cr; hsi = ci;
#pragma unroll
                for (int i = 0; i < 8; ++i) {
                    *(LAS bf16_t*)(lds + L_HIN + (8 * w + i) * 272 + lane * 2) = f2bf(xr[i] + myr); *(LAS bf16_t*)(lds + L_HIN + (8 * w + i) * 272 + (64 + lane) * 2) = f2bf(xi[i] + myi);
                    const float nr = l8r * myr - l8i * myi, ni = l8r * myi + l8i * myr; myr = nr; myi = ni;
                }
                lds_barrier();
                ssm_pass_c(p, lds, 4, w, fr, fq, g, tok_base);
                lds_barrier();
            }
            if (w == 0) { p.out[O_SRP + ((size_t)b * 64 + g) * 64 + lane] = hsr; p.out[O_SIP + ((size_t)b * 64 + g) * 64 + lane] = hsi; }
        } else {
            const int b0 = sub * 32, tok_base = MP + b0 * 8;
            float h0r[4], h0i[4];
            if (pref) {
#pragma unroll
                for (int j = 0; j < 4; ++j) { h0r[j] = ph0r[j]; h0i[j] = ph0i[j]; }
            } else {
                if (tid < 256) { const u32x4* src = (const u32x4*)(PU + ((size_t)g * MT + tok_base + tid) * 16); pua = src[0]; puc = src[1]; }
#pragma unroll
                for (int j = 0; j < 4; ++j) {
                    const int e = tid + 512 * j, rr = e >> 6, pp = e & 63;
                    const size_t o = ((size_t)(b0 + rr) * 64 + g) * 64 + pp;
                    h0r[j] = p.st_re[o]; h0i[j] = p.st_im[o];
                }
            }
            pref = false;
            if (tid < 256) { LAS unsigned char* d = lds + L_U + (tid >> 3) * 272 + (tid & 7) * 32; *(LAS u32x4*)d = pua; *(LAS u32x4*)(d + 16) = puc; }
#pragma unroll
            for (int j = 0; j < 4; ++j) {
                const int e = tid + 512 * j, rr = e >> 6, pp = e & 63;
                *(LAS bf16_t*)(lds + L_HIN + rr * 272 + pp * 2) = f2bf(h0r[j]); *(LAS bf16_t*)(lds + L_HIN + rr * 272 + (64 + pp) * 2) = f2bf(h0i[j]);
            }
            __syncthreads();
            ssm_pass_a(lds, 2, w, fr, fq);
            __syncthreads();
#pragma unroll
            for (int j = 0; j < 4; ++j) {
                const int e = tid + 512 * j, rr = e >> 6, pp = e & 63;
                const size_t o = ((size_t)(b0 + rr) * 64 + g) * 64 + pp;
                const float sr = S[rr * 128 + pp], si = S[rr * 128 + 64 + pp];
                p.out[O_SRS + o] = l8r * h0r[j] - l8i * h0i[j] + sr; p.out[O_SIS + o] = l8r * h0i[j] + l8i * h0r[j] + si;
            }
            ssm_pass_c(p, lds, 2, w, fr, fq, g, tok_base);
            __syncthreads();
        }
    }
    if (ci < CONV_ITEMS) { if (!cpref) conv_issue<0, 4>(p, ci, cq, cb); conv_issue<4, 8>(p, ci, cq, cb); conv_finish(p, ci, cq, cb); }
    { const int G = gridDim.x, rest = CONV_ITEMS - G * 512;
      if (rest > 0) { const int per = (rest + G - 1) / G;
        for (int k = tid; k < per; k += 512) { const int i = G * 512 + blockIdx.x * per + k; if (i < CONV_ITEMS) { conv_issue<0, 8>(p, i, cq, cb); conv_finish(p, i, cq, cb); } } } }
}

__device__ __forceinline__ void phase_ln(const Params& p) {
    const int tl = tid_opaque(), lane = tl & 63, wv = tl >> 6;
    for (int row = blockIdx.x * 8 + wv; row < MT; row += gridDim.x * 8) {
        float* r = p.out + (size_t)row * D_MODEL;
        f32x4 v[8]; float s = 0.f;
#pragma unroll
        for (int j = 0; j < 8; ++j) { v[j] = *(const f32x4*)(r + j * 256 + lane * 4); s += v[j][0] + v[j][1] + v[j][2] + v[j][3]; }
#pragma unroll
        for (int o = 32; o > 0; o >>= 1) s += __shfl_xor(s, o);
        const float mu = s * (1.0f / D_MODEL);
        float q = 0.f;
#pragma unroll
        for (int j = 0; j < 8; ++j) { v[j] = v[j] - mu; q += v[j][0] * v[j][0] + v[j][1] * v[j][1] + v[j][2] * v[j][2] + v[j][3] * v[j][3]; }
#pragma unroll
        for (int o = 32; o > 0; o >>= 1) q += __shfl_xor(q, o);
        const float rs = rsqrtf(q * (1.0f / D_MODEL) + LN_EPS);
#pragma unroll
        for (int j = 0; j < 8; ++j) { const f32x4 gg = *(const f32x4*)(p.ln_g + j * 256 + lane * 4), bb = *(const f32x4*)(p.ln_b + j * 256 + lane * 4);
            *(f32x4*)(r + j * 256 + lane * 4) = v[j] * rs * gg + bb; }
    }
}

namespace flow {
using namespace pg8;
enum { T_GLU = 0, T_C = 1, T_A = 2, T_O1 = 3, T_O2 = 4 };
struct FUnit { int type, pm, pn, h; };
constexpr int NJ_GLU = 144, NJ_PAIR = 288, NJ_OF = 224, NJ_OH = 128, NJOBS = NJ_GLU + NJ_PAIR + NJ_OF + NJ_OH;
constexpr int CTL_QHEAD = 0, CTL_PRE = 64, CTL_LNQ = 64 * 120, NJ_LN = 576;
__host__ __device__ constexpr int CTL_G(int pm) { return 64 * (2 + pm); }
__host__ __device__ constexpr int CTL_M(int pm) { return 64 * (40 + pm); }
__host__ __device__ constexpr int CTL_R(int pm) { return 64 * (80 + pm); }
constexpr size_t HSZ = (size_t)MT * 1024 * 2, WSZ = (size_t)2048 * 1024 * 2, TSTEP = (size_t)256 * 1024 * 2;
__device__ __forceinline__ const char* unitA(const unsigned char* ws, const FUnit& u) {
    const size_t off = u.type == T_GLU ? W_G1 : u.type == T_C ? W_YAC + HSZ : u.type == T_A ? W_YAC : u.type == T_O1 ? W_MG : W_MG + HSZ;
    return (const char*)ws + off + (size_t)u.pm * TSTEP + (u.h == 2 ? TSTEP / 2 : 0);
}
__device__ __forceinline__ const char* unitB(const unsigned char* ws, const FUnit& u) {
    const size_t off = u.type == T_GLU ? W_WGLUT : u.type == T_C ? W_WOACT + WSZ : u.type == T_A ? W_WOACT : u.type == T_O1 ? W_WOT : W_WOT + WSZ;
    return (const char*)ws + off + (size_t)u.pn * TSTEP;
}
__device__ __forceinline__ void st_wt(__amdgpu_buffer_rsrc_t r, size_t byte_off, u32x4 v) { __builtin_amdgcn_raw_buffer_store_b128(v, r, (unsigned)byte_off, 0, 16); }

__device__ __forceinline__ void epilogue(const Params& p, const f32x4 (&acc)[2][2][4][2], const FUnit& u, int wr, int wc, int fr, int fq) {
    unsigned char* ws = p.ws;
    if (u.type == T_GLU) {
        const bf16_t* G1 = (const bf16_t*)(ws + W_G1); const bf16_t* ZA = (const bf16_t*)(ws + W_PZA);
        const __amdgpu_buffer_rsrc_t rs = __builtin_amdgcn_make_buffer_rsrc(ws + W_YAC, 0, (int)HSZ, 0x00020000);
        EPI_HALF_BEGIN
            u32x4 gv[4][2], zv[4][2];
            EPI_MB_LOOP { const size_t o = (size_t)(u.pm * 256 + EPI_RL) * 1024 + u.pn * 256 + EPI_CL; gv[m][bj] = *(const u32x4*)(G1 + o); zv[m][bj] = *(const u32x4*)(ZA + o); }
            EPI_MB_LOOP { const size_t o = (size_t)(u.pm * 256 + EPI_RL) * 1024 + u.pn * 256 + EPI_CL;
                const f32x4 v0 = acc[ai][bj][m][0], v1 = acc[ai][bj][m][1]; const u32x4 g = gv[m][bj], z = zv[m][bj];
                f32x4 a, b;
                a[0] = bf_lo(g[0]) * sigmoidf_(v0[0]) * bf_lo(z[0]); a[1] = bf_hi(g[0]) * sigmoidf_(v0[1]) * bf_hi(z[0]);
                a[2] = bf_lo(g[1]) * sigmoidf_(v0[2]) * bf_lo(z[1]); a[3] = bf_hi(g[1]) * sigmoidf_(v0[3]) * bf_hi(z[1]);
                b[0] = bf_lo(g[2]) * sigmoidf_(v1[0]) * bf_lo(z[2]); b[1] = bf_hi(g[2]) * sigmoidf_(v1[1]) * bf_hi(z[2]);
                b[2] = bf_lo(g[3]) * sigmoidf_(v1[2]) * bf_lo(z[3]); b[3] = bf_hi(g[3]) * sigmoidf_(v1[3]) * bf_hi(z[3]);
                st_wt(rs, o * 2, pack8(a, b)); }
        EPI_HALF_END
    } else if (u.type == T_A) {
        const bf16_t* SA = (const bf16_t*)(ws + W_PGA);
        const __amdgpu_buffer_rsrc_t rs = __builtin_amdgcn_make_buffer_rsrc(ws + W_MG, 0, (int)(2 * HSZ), 0x00020000);
        const size_t hoff = (size_t)(u.pn >> 2) * HSZ;
        u32x4 gv[2][4][2];
        EPI_HALF_BEGIN
            EPI_MB_LOOP { const size_t o = (size_t)(u.pm * 256 + EPI_RL) * 2048 + u.pn * 256 + EPI_CL; gv[ai][m][bj] = *(const u32x4*)(SA + o); }
        EPI_HALF_END
        EPI_HALF_BEGIN
            EPI_MB_LOOP { const size_t o = (size_t)(u.pm * 256 + EPI_RL) * 1024 + (u.pn & 3) * 256 + EPI_CL;
                const f32x4 v0 = acc[ai][bj][m][0], v1 = acc[ai][bj][m][1]; const u32x4 g = gv[ai][m][bj];
                f32x4 a, b;
                a[0] = bf_lo(g[0]) * v0[0]; a[1] = bf_hi(g[0]) * v0[1]; a[2] = bf_lo(g[1]) * v0[2]; a[3] = bf_hi(g[1]) * v0[3];
                b[0] = bf_lo(g[2]) * v1[0]; b[1] = bf_hi(g[2]) * v1[1]; b[2] = bf_lo(g[3]) * v1[2]; b[3] = bf_hi(g[3]) * v1[3];
                st_wt(rs, hoff + o * 2, pack8(a, b)); }
        EPI_HALF_END
    } else {
        const int rbase = u.pm * 256 + (u.h == 2 ? 128 : 0);
        const bf16_t* XB = (const bf16_t*)(ws + W_XB);
        const __amdgpu_buffer_rsrc_t rsr = __builtin_amdgcn_make_buffer_rsrc(ws + W_PH, 0, (int)(2 * HSZ), 0x00020000);
        u32x4 xv[2][4][2];
        EPI_HALF_BEGIN
            if (u.h != 0 && ai == 1) break;
            EPI_MB_LOOP { const size_t o = (size_t)(rbase + EPI_RL) * D_MODEL + u.pn * 256 + EPI_CL; xv[ai][m][bj] = *(const u32x4*)(XB + o); }
        EPI_HALF_END
        EPI_HALF_BEGIN
            if (u.h != 0 && ai == 1) break;
            EPI_MB_LOOP { const size_t o = (size_t)(rbase + EPI_RL) * D_MODEL + u.pn * 256 + EPI_CL;
                const u32x4 x = xv[ai][m][bj]; const f32x4 v0 = acc[ai][bj][m][0], v1 = acc[ai][bj][m][1];
                f32x4 a, b;
                a[0] = bf_lo(x[0]) * DN_ALPHA + v0[0]; a[1] = bf_hi(x[0]) * DN_ALPHA + v0[1]; a[2] = bf_lo(x[1]) * DN_ALPHA + v0[2]; a[3] = bf_hi(x[1]) * DN_ALPHA + v0[3];
                b[0] = bf_lo(x[2]) * DN_ALPHA + v1[0]; b[1] = bf_hi(x[2]) * DN_ALPHA + v1[1]; b[2] = bf_lo(x[3]) * DN_ALPHA + v1[2]; b[3] = bf_hi(x[3]) * DN_ALPHA + v1[3];
                st_wt(rsr, o * 2, pack8(a, b)); }
        EPI_HALF_END
    }
}

__device__ __forceinline__ void ln_rows(const Params& p, int row0, int nrows, int lane) {
    const bf16_t* R = (const bf16_t*)(p.ws + W_PH);
    for (int row = row0; row < row0 + nrows; ++row) {
        const bf16_t* r = R + (size_t)row * D_MODEL;
        float v[32]; float s = 0.f;
#pragma unroll
        for (int j = 0; j < 4; ++j) { const u32x4 w = *(const u32x4*)(r + j * 512 + lane * 8);
#pragma unroll
            for (int q = 0; q < 4; ++q) { v[j * 8 + 2 * q] = bf_lo(w[q]); v[j * 8 + 2 * q + 1] = bf_hi(w[q]); } }
#pragma unroll
        for (int j = 0; j < 32; ++j) s += v[j];
#pragma unroll
        for (int o = 32; o > 0; o >>= 1) s += __shfl_xor(s, o);
        const float mu = s * (1.0f / D_MODEL);
        float q2 = 0.f;
#pragma unroll
        for (int j = 0; j < 32; ++j) { v[j] -= mu; q2 += v[j] * v[j]; }
#pragma unroll
        for (int o = 32; o > 0; o >>= 1) q2 += __shfl_xor(q2, o);
        const float rs = rsqrtf(q2 * (1.0f / D_MODEL) + LN_EPS);
        float* o = p.out + (size_t)row * D_MODEL;
#pragma unroll
        for (int j = 0; j < 4; ++j)
#pragma unroll
            for (int h = 0; h < 2; ++h) { const int c = j * 512 + lane * 8 + h * 4; const f32x4 gg = *(const f32x4*)(p.ln_g + c), bb = *(const f32x4*)(p.ln_b + c);
                f32x4 y; y[0] = v[j * 8 + h * 4] * rs * gg[0] + bb[0]; y[1] = v[j * 8 + h * 4 + 1] * rs * gg[1] + bb[1]; y[2] = v[j * 8 + h * 4 + 2] * rs * gg[2] + bb[2]; y[3] = v[j * 8 + h * 4 + 3] * rs * gg[3] + bb[3];
                *(f32x4*)(o + c) = y; }
    }
}

__device__ __forceinline__ void gemm_flow(LAS unsigned char* lds, const Params& p, unsigned npre) {
    const int tid = tid_opaque(), wid = __builtin_amdgcn_readfirstlane(tid >> 6), lane = tid & 63, wr = wid >> 2, wc = wid & 3, fr = lane & 15, fq = lane >> 4;
    constexpr int K = 1024, nt = K / BK;
    unsigned* ctl = (unsigned*)(p.ws + W_CTL);
    volatile LAS unsigned* slot = (volatile LAS unsigned*)(lds + LDS_BYTES - 32);
    unsigned voffA[2], voffB[2];
#pragma unroll
    for (int i = 0; i < 2; ++i) { int R, C; stage_rc(tid * 16 + i * 8192, R, C); const int Rb = (R & ~31) + perm32(R & 31);
        voffA[i] = (unsigned)(R * K + C) * 2u; voffB[i] = (unsigned)(Rb * K + C) * 2u; }
    const size_t kstep = (size_t)(BK * 2);
    const size_t hstep = (size_t)HALF * K * 2;
    const unsigned ldsw = (unsigned)wid * 1024u;
    const int aoff = lds_byte(wr * 64 + fr, fq * 8), boff = lds_byte(wc * 32 + fr, fq * 8);
#define PG8_SA(b, h) (((b) * 2 + (h)) * HTB)
#define PG8_SB(b, h) ((4 + (b) * 2 + (h)) * HTB)
#define PG8_STAGE(bufoff, gbase, voff) do { _Pragma("unroll") for (int _i = 0; _i < 2; ++_i) \
        __builtin_amdgcn_global_load_lds((const unsigned*)((const char*)(gbase) + (voff)[_i]), (LAS unsigned*)(lds + (bufoff) + ldsw + _i * 8192), 16, 0, 0); } while (0)
#define PG8_LDA(dst, b, h) do { _Pragma("unroll") for (int m = 0; m < 4; ++m) _Pragma("unroll") for (int k = 0; k < 2; ++k) dst[m][k] = *(const LAS bf16x8*)(lds + PG8_SA(b, h) + aoff + m * 2048 + k * 1024); } while (0)
#define PG8_LDB(dst, b, h) do { _Pragma("unroll") for (int n = 0; n < 2; ++n) _Pragma("unroll") for (int k = 0; k < 2; ++k) dst[n][k] = *(const LAS bf16x8*)(lds + PG8_SB(b, h) + boff + n * 2048 + k * 1024); } while (0)
#define PG8_MMA(ai, bj, At, Bt) do { __builtin_amdgcn_s_setprio(1); _Pragma("unroll") for (int m = 0; m < 4; ++m) _Pragma("unroll") for (int n = 0; n < 2; ++n) _Pragma("unroll") for (int k = 0; k < 2; ++k) \
        acc[ai][bj][m][n] = __builtin_amdgcn_mfma_f32_16x16x32_bf16(Bt[n][k], At[m][k], acc[ai][bj][m][n], 0, 0, 0); __builtin_amdgcn_s_setprio(0); } while (0)
#define PG8_WAIT_V(n) asm volatile("s_waitcnt vmcnt(" #n ")" ::: "memory")
#define PG8_WAIT_L(n) asm volatile("s_waitcnt lgkmcnt(" #n ")" ::: "memory")
#define PG8_BAR __builtin_amdgcn_s_barrier()
#define PG8_SCHED __builtin_amdgcn_sched_barrier(0)
    bool pend = false;
#define FLOW_NEXT(prevu, outu, has) do { \
        if (pend) { outu.type = prevu.type + 1; outu.pm = prevu.pm; outu.pn = prevu.pn; outu.h = prevu.h; pend = false; has = true; } \
        else { if (tid == 0) { const unsigned _j = __hip_atomic_fetch_add(ctl + CTL_QHEAD, 1u, __ATOMIC_RELAXED, __HIP_MEMORY_SCOPE_AGENT); *slot = _j; asm volatile("s_waitcnt lgkmcnt(0)" ::: "memory"); } \
            asm volatile("" ::: "memory"); PG8_BAR; asm volatile("" ::: "memory"); \
            const int _jb = __builtin_amdgcn_readfirstlane((int)*slot); \
            if (_jb >= NJOBS) has = false; \
            else { has = true; outu.h = 0; \
                if (_jb < NJ_GLU) { outu.type = T_GLU; outu.pm = _jb >> 2; outu.pn = _jb & 3; } \
                else if (_jb < NJ_GLU + NJ_PAIR) { const int _q = _jb - NJ_GLU; outu.type = T_C; outu.pm = _q >> 3; outu.pn = _q & 7; pend = true; } \
                else { const int _q = _jb - NJ_GLU - NJ_PAIR; outu.type = T_O1; pend = true; \
                    if (_q < NJ_OF) { outu.pm = _q >> 3; outu.pn = _q & 7; } \
                    else { const int _r = _q - NJ_OF, _t = _r >> 1; outu.pm = (NJ_OF >> 3) + (_t >> 3); outu.pn = _t & 7; outu.h = 1 + (_r & 1); } } } } } while (0)
#define FLOW_READY(uu) do { \
        if ((uu.type == T_C && npre != 0u) || uu.type == T_A || uu.type == T_O1) { \
            if (wid == 0) { const unsigned* _c = ctl + (uu.type == T_C ? CTL_PRE : uu.type == T_A ? CTL_G(uu.pm) : CTL_M(uu.pm)); const unsigned _need = uu.type == T_C ? npre : uu.type == T_A ? 32u : 64u; \
                unsigned _polls = 0; while ((unsigned)__builtin_amdgcn_readfirstlane(__hip_atomic_load(_c, __ATOMIC_RELAXED, __HIP_MEMORY_SCOPE_AGENT)) < _need) { __builtin_amdgcn_s_sleep(2); if (++_polls > (1u << 20)) break; } \
                asm volatile("s_waitcnt vmcnt(0)" ::: "memory"); } \
            asm volatile("" ::: "memory"); PG8_BAR; asm volatile("" ::: "memory"); } } while (0)
#define FLOW_DONE(uu) do { \
        if (uu.type == T_GLU || uu.type == T_A || uu.type == T_O2) { asm volatile("s_waitcnt vmcnt(0)" ::: "memory"); \
            if (lane == 0) (void)__hip_atomic_fetch_add(ctl + (uu.type == T_GLU ? CTL_G(uu.pm) : uu.type == T_A ? CTL_M(uu.pm) : CTL_R(uu.pm)), 1u, __ATOMIC_RELAXED, __HIP_MEMORY_SCOPE_AGENT); } } while (0)
    FUnit cur, nxt; bool has_cur;
    cur.type = 0; cur.pm = 0; cur.pn = 0; cur.h = 0; nxt = cur;
    FLOW_NEXT(cur, cur, has_cur);
    if (has_cur) {
    f32x4 acc[2][2][4][2];
#pragma unroll
    for (int a = 0; a < 2; ++a)
#pragma unroll
        for (int b = 0; b < 2; ++b)
#pragma unroll
            for (int m = 0; m < 4; ++m)
#pragma unroll
                for (int n = 0; n < 2; ++n) acc[a][b][m][n] = (f32x4){0.f, 0.f, 0.f, 0.f};
    bf16x8 At[4][2], B0[2][2], B1[2][2];
    for (;;) {
        const char* cA = unitA(p.ws, cur); const char* cB = unitB(p.ws, cur);
        FLOW_READY(cur);
        PG8_STAGE(PG8_SB(0, 0), cB, voffB); PG8_STAGE(PG8_SA(0, 0), cA, voffA); PG8_STAGE(PG8_SB(0, 1), cB + hstep, voffB); PG8_STAGE(PG8_SA(0, 1), cA + hstep, voffA);
        if (wr == 1) PG8_BAR;
        PG8_WAIT_V(4); PG8_BAR;
        PG8_STAGE(PG8_SB(1, 0), cB + kstep, voffB); PG8_STAGE(PG8_SA(1, 0), cA + kstep, voffA); PG8_STAGE(PG8_SB(1, 1), cB + hstep + kstep, voffB);
        PG8_WAIT_V(6); PG8_BAR;
        bool has_next;
        for (;;) {
            FLOW_NEXT(cur, nxt, has_next);
            const bool chain = has_next && nxt.type != T_O1;
            const bool full = cur.h == 0;
            const char* nA = chain ? unitA(p.ws, nxt) : cA; const char* nB = chain ? unitB(p.ws, nxt) : cB;
            for (int t = 0; t < nt; t += 2) {
                const bool last = (t == nt - 2);
                const char* a1 = cA + (size_t)(t + 1) * kstep;
                const char* a2 = last ? nA : cA + (size_t)(t + 2) * kstep; const char* b2 = last ? nB : cB + (size_t)(t + 2) * kstep;
                const char* a3 = a2 + kstep; const char* b3 = b2 + kstep;
                if (last && chain) FLOW_READY(nxt);
                PG8_LDB(B0, 0, 0); PG8_SCHED; PG8_LDA(At, 0, 0); PG8_STAGE(PG8_SA(1, 1), a1 + hstep, voffA);
                PG8_WAIT_L(8); PG8_BAR; PG8_WAIT_L(0); PG8_MMA(0, 0, At, B0); PG8_BAR; PG8_SCHED;
                PG8_LDB(B1, 0, 1); PG8_STAGE(PG8_SB(0, 0), b2, voffB);
                PG8_BAR; PG8_WAIT_L(0); PG8_MMA(0, 1, At, B1); PG8_BAR;
                PG8_LDA(At, 0, 1); PG8_STAGE(PG8_SA(0, 0), a2, voffA);
                PG8_BAR; PG8_WAIT_L(0); if (full) PG8_MMA(1, 0, At, B0); PG8_BAR; PG8_SCHED;
                PG8_STAGE(PG8_SB(0, 1), b2 + hstep, voffB);
                PG8_WAIT_V(6); PG8_BAR; if (full) PG8_MMA(1, 1, At, B1); PG8_BAR;
                PG8_LDB(B0, 1, 0); PG8_SCHED; PG8_LDA(At, 1, 0); PG8_STAGE(PG8_SA(0, 1), a2 + hstep, voffA);
                PG8_WAIT_L(8); PG8_BAR; PG8_WAIT_L(0); PG8_MMA(0, 0, At, B0); PG8_BAR; PG8_SCHED;
                PG8_LDB(B1, 1, 1); PG8_STAGE(PG8_SB(1, 0), b3, voffB);
                PG8_BAR; PG8_WAIT_L(0); PG8_MMA(0, 1, At, B1); PG8_BAR;
                PG8_LDA(At, 1, 1); PG8_STAGE(PG8_SA(1, 0), a3, voffA);
                PG8_BAR; PG8_WAIT_L(0); if (full) PG8_MMA(1, 0, At, B0); PG8_BAR; PG8_SCHED;
                PG8_STAGE(PG8_SB(1, 1), b3 + hstep, voffB);
                PG8_WAIT_V(6); PG8_BAR; if (full) PG8_MMA(1, 1, At, B1); PG8_BAR;
            }
            if (cur.type != T_C && cur.type != T_O1) { epilogue(p, acc, cur, wr, wc, fr, fq); FLOW_DONE(cur); }
            if (!chain) break;
            {
                const bool isTC = cur.type == T_C;
                const unsigned kbits = (nxt.type == T_O2) ? 0x3F803F80u : 0u;
                const bf16_t* RT = (const bf16_t*)(p.ws + W_PGC);
                u32x4 gv[2][4][2];
                EPI_HALF_BEGIN
                    if (isTC) { EPI_MB_LOOP { const size_t o = (size_t)(cur.pm * 256 + EPI_RL) * 2048 + cur.pn * 256 + EPI_CL; gv[ai][m][bj] = *(const u32x4*)(RT + o); } }
                    else { EPI_MB_LOOP gv[ai][m][bj] = (u32x4){kbits, kbits, kbits, kbits}; }
                EPI_HALF_END
                EPI_HALF_BEGIN
                    EPI_MB_LOOP { const u32x4 g = gv[ai][m][bj];
                        acc[ai][bj][m][0][0] *= bf_lo(g[0]); acc[ai][bj][m][0][1] *= bf_hi(g[0]); acc[ai][bj][m][0][2] *= bf_lo(g[1]); acc[ai][bj][m][0][3] *= bf_hi(g[1]);
                        acc[ai][bj][m][1][0] *= bf_lo(g[2]); acc[ai][bj][m][1][1] *= bf_hi(g[2]); acc[ai][bj][m][1][2] *= bf_lo(g[3]); acc[ai][bj][m][1][3] *= bf_hi(g[3]); }
                EPI_HALF_END
            }
            cur = nxt; cA = nA; cB = nB;
        }
        PG8_WAIT_V(0);
        if (wr == 0) PG8_BAR;
        PG8_BAR;
        if (!has_next) break;
#pragma unroll
        for (int a = 0; a < 2; ++a)
#pragma unroll
            for (int b = 0; b < 2; ++b)
#pragma unroll
                for (int m = 0; m < 4; ++m)
#pragma unroll
                    for (int n = 0; n < 2; ++n) acc[a][b][m][n] = (f32x4){0.f, 0.f, 0.f, 0.f};
        cur = nxt;
    }
    }
    __syncthreads();
    for (;;) {
        if (tid == 0) { const unsigned _j = __hip_atomic_fetch_add(ctl + CTL_LNQ, 1u, __ATOMIC_RELAXED, __HIP_MEMORY_SCOPE_AGENT); *slot = _j; }
        __syncthreads();
        const int j = __builtin_amdgcn_readfirstlane((int)*slot);
        if (j >= NJ_LN) break;
        const int pm = j >> 4, part = j & 15;
        if (wid == 0) { const unsigned* _c = ctl + CTL_R(pm); const unsigned _need = pm < (NJ_OF >> 3) ? 64u : 128u;
            unsigned _polls = 0; while ((unsigned)__builtin_amdgcn_readfirstlane(__hip_atomic_load(_c, __ATOMIC_RELAXED, __HIP_MEMORY_SCOPE_AGENT)) < _need) { __builtin_amdgcn_s_sleep(16); if (++_polls > (1u << 20)) break; }
            asm volatile("s_waitcnt vmcnt(0)" ::: "memory"); }
        __syncthreads();
        ln_rows(p, pm * 256 + part * 16 + wid * 2, 2, lane);
    }
#undef FLOW_NEXT
#undef FLOW_READY
#undef FLOW_DONE
#undef PG8_SA
#undef PG8_SB
#undef PG8_STAGE
#undef PG8_LDA
#undef PG8_LDB
#undef PG8_MMA
#undef PG8_WAIT_V
#undef PG8_WAIT_L
#undef PG8_BAR
#undef PG8_SCHED
}
}

__device__ __forceinline__ void run_phase(const Params& p, LAS unsigned char* lds, int ph) {
    const int G = gridDim.x, c = blockIdx.x;
    if (ph == 0) { phase_convert(p, lds); }
    else if (ph == 1) { pg8::StaticOrder S; S.init(36, 40, G, c); pg8::Gemm g{(const bf16_t*)(p.ws + W_XB), (const bf16_t*)(p.ws + W_WINT), 2048}; EpiProj E{p.ws}; pg8::gemm_phase(lds, g, S, E);
        const int rem = 1440 % G; if (rem == 0) phase_convert_late(p, lds, c, G); else if (c >= rem) phase_convert_late(p, lds, c - rem, G - rem); }
    else if (ph == 2) { phase_ssm(p, lds); }
    else if (ph == 3) {
        const int npre = 0;
        flow::gemm_flow(lds, p, (unsigned)npre);
    }
    else { phase_ln(p); }
}

extern __shared__ __attribute__((aligned(16))) unsigned char dyn_lds[];

#if MK_SINGLE
__global__ __launch_bounds__(512, 2) void mega_kernel(Params p) {
    LAS unsigned char* lds = (LAS unsigned char*)dyn_lds;
    if (__builtin_expect(p.ws == nullptr, 0)) cg::this_grid().sync();
    volatile LAS unsigned* st = (volatile LAS unsigned*)(lds + LDS_BYTES - 16);
    if (threadIdx.x == 0) { st[0] = 0u; st[1] = 0u; st[2] = 0u; st[3] = 0u; }
    __syncthreads();
    const XcdBarrier xb = xcd_barrier_post((unsigned*)(p.ws + W_BAR), st);
#ifndef PROBE_DUP
#define PROBE_DUP -1
#endif
#ifndef PROBE_SYNCS
#define PROBE_SYNCS 0
#endif
#define RUNP(k) do { run_phase(p, lds, k); xcd_barrier(xb); if (PROBE_DUP == k) { run_phase(p, lds, k); xcd_barrier(xb); } for (int _s = 0; _s < PROBE_SYNCS; ++_s) xcd_barrier(xb); } while (0)
    RUNP(0); RUNP(1); RUNP(2);
    run_phase(p, lds, 3);
}
#endif
template <int PH> __global__ __launch_bounds__(512, 2) void phase_kernel(Params p) {
    LAS unsigned char* lds = (LAS unsigned char*)dyn_lds;
    run_phase(p, lds, PH);
}

extern "C" void kernel_launch(void* const* d_in, const int* in_sizes, int n_in, void* d_out, int out_size, void* d_ws, size_t ws_size, hipStream_t stream) {
    Params p{};
    p.x_prompt = (const float*)d_in[0]; p.x_sample = (const float*)d_in[1]; p.st_re = (const float*)d_in[2]; p.st_im = (const float*)d_in[3]; p.st_conv = (const float*)d_in[4];
    p.w_in = (const float*)d_in[5]; p.a_re = (const float*)d_in[6]; p.a_im = (const float*)d_in[7]; p.log_dt = (const float*)d_in[8]; p.b_re = (const float*)d_in[9]; p.b_im = (const float*)d_in[10];
    p.c_re = (const float*)d_in[11]; p.c_im = (const float*)d_in[12]; p.ssm_d = (const float*)d_in[13]; p.w_glu = (const float*)d_in[14]; p.w_out_a = (const float*)d_in[15]; p.conv_w = (const float*)d_in[16];
    p.w_out_c = (const float*)d_in[17]; p.w_o = (const float*)d_in[18]; p.ln_g = (const float*)d_in[19]; p.ln_b = (const float*)d_in[20];
    p.out = (float*)d_out; p.ws = (unsigned char*)d_ws;
    if (ws_size < W_END) { fprintf(stderr, "workspace too small: %zu < %zu\n", ws_size, (size_t)W_END); return; }
#if MK_SINGLE
    static int grid_blocks = 0;
    if (!grid_blocks) {
        int dev = 0, cus = 0, per_cu = 0;
        hipGetDevice(&dev);
        hipDeviceGetAttribute(&cus, hipDeviceAttributeMultiprocessorCount, dev);
        hipFuncSetAttribute((const void*)mega_kernel, hipFuncAttributeMaxDynamicSharedMemorySize, LDS_BYTES);
        hipOccupancyMaxActiveBlocksPerMultiprocessor(&per_cu, mega_kernel, 512, LDS_BYTES);
        if (per_cu < 1) per_cu = 1;
        grid_blocks = cus * per_cu; if (grid_blocks > 256) grid_blocks = 256;
    }
    (void)hipMemsetAsync(p.ws + W_BAR, 0, 16384 + 32768, stream);
    void* args[] = {&p};
    hipError_t e = hipLaunchCooperativeKernel((const void*)mega_kernel, dim3(grid_blocks), dim3(512), args, LDS_BYTES, stream);
    if (e != hipSuccess) fprintf(stderr, "cooperative launch failed: %s (grid %d)\n", hipGetErrorString(e), grid_blocks);
#else
    static bool attr = false;
    if (!attr) {
        hipFuncSetAttribute((const void*)phase_kernel<0>, hipFuncAttributeMaxDynamicSharedMemorySize, LDS_BYTES); hipFuncSetAttribute((const void*)phase_kernel<1>, hipFuncAttributeMaxDynamicSharedMemorySize, LDS_BYTES);
        hipFuncSetAttribute((const void*)phase_kernel<2>, hipFuncAttributeMaxDynamicSharedMemorySize, LDS_BYTES); hipFuncSetAttribute((const void*)phase_kernel<3>, hipFuncAttributeMaxDynamicSharedMemorySize, LDS_BYTES);
        hipFuncSetAttribute((const void*)phase_kernel<4>, hipFuncAttributeMaxDynamicSharedMemorySize, LDS_BYTES); hipFuncSetAttribute((const void*)phase_kernel<5>, hipFuncAttributeMaxDynamicSharedMemorySize, LDS_BYTES);
        hipFuncSetAttribute((const void*)phase_kernel<6>, hipFuncAttributeMaxDynamicSharedMemorySize, LDS_BYTES); attr = true;
    }
    phase_kernel<0><<<256, 512, LDS_BYTES, stream>>>(p);
    phase_kernel<1><<<256, 512, LDS_BYTES, stream>>>(p);
    phase_kernel<2><<<256, 512, LDS_BYTES, stream>>>(p);
    phase_kernel<3><<<256, 512, LDS_BYTES, stream>>>(p);
    phase_kernel<4><<<256, 512, LDS_BYTES, stream>>>(p);
    phase_kernel<5><<<256, 512, LDS_BYTES, stream>>>(p);
    phase_kernel<6><<<256, 512, LDS_BYTES, stream>>>(p);
#endif
}
```
